# Optimizing an MI355X kernel written in HIP

```python
import jax, jax.numpy as jnp
from jax import lax
import numpy as np

D_MODEL = 1024
BATCH = 4
SEQ = 8192
DEPTH = 2

HEAD_DIM = 64
RWKV_WIDTH = D_MODEL // 2
ATTN_WIDTH = D_MODEL - RWKV_WIDTH
RWKV_HEADS = RWKV_WIDTH // HEAD_DIM
ATTN_Q_HEADS = ATTN_WIDTH // HEAD_DIM
ATTN_KV_HEADS = 2
GQA_GROUP = ATTN_Q_HEADS // ATTN_KV_HEADS
KV_WIDTH = ATTN_KV_HEADS * HEAD_DIM
WINDOW = 128
BLOCK = WINDOW
DECAY_LORA = 64
ICLR_LORA = 64
SHIFT_WIDTH = 3 * RWKV_WIDTH + DECAY_LORA + ICLR_LORA
IN_WIDTH = SHIFT_WIDTH + RWKV_WIDTH + ATTN_WIDTH + 2 * KV_WIDTH + ATTN_WIDTH
NORM_EPS = 1e-5
GN_EPS = 64e-5

kernel_name = "hymba_rwkv7_swa_sink_hybrid"


def rmsnorm(x, gain):
    xf = x.astype(jnp.float32)
    y = xf * lax.rsqrt(jnp.mean(xf * xf, axis=-1, keepdims=True) + NORM_EPS)
    return (y * gain.astype(jnp.float32)).astype(x.dtype)


def token_shift(p, mu):
    prev = jnp.pad(p[:, :-1], ((0, 0), (1, 0), (0, 0)))
    return p + (prev - p) * mu


def rwkv7_step(S, inp):
    r_t, w_t, k_t, v_t, a_t, b_t = inp
    sa = jnp.einsum('bhij,bhj->bhi', S, a_t)
    S = S * w_t[:, :, None, :] + sa[..., None] * b_t[:, :, None, :] + v_t[..., None] * k_t[:, :, None, :]
    y = jnp.einsum('bhij,bhj->bhi', S, r_t)
    return S, y


def rwkv7_mix(shifted, g, w0, w_up, a0, a_up, k_k, k_a, r_k, gn_w, gn_b):
    B, T, _ = shifted.shape
    H, N = RWKV_HEADS, HEAD_DIM
    f32 = jnp.float32
    r, k, v, wd, ad = jnp.split(shifted, np.cumsum([RWKV_WIDTH, RWKV_WIDTH, RWKV_WIDTH, DECAY_LORA])[:].tolist(), axis=-1)
    r, k, v, wd, ad = [t.astype(f32) for t in (r, k, v, wd, ad)]
    w = -jax.nn.softplus(-(w0.astype(f32) + jnp.tanh(wd) @ w_up.astype(f32))) - 0.5
    decay = jnp.exp(-jnp.exp(w))
    a = jax.nn.sigmoid(a0.astype(f32) + ad @ a_up.astype(f32))
    kk = (k * k_k.astype(f32)).reshape(B, T, H, N)
    kk = kk / jnp.maximum(jnp.sqrt(jnp.sum(kk * kk, axis=-1, keepdims=True)), 1e-12)
    k = k * (1.0 + (a - 1.0) * k_a.astype(f32))
    rh, wh, kh, vh, ah = [t.reshape(B, T, H, N) for t in (r, decay, k, v, a)]
    a_vec = -kk
    b_vec = kk * ah
    xs = tuple(jnp.moveaxis(t, 1, 0) for t in (rh, wh, kh, vh, a_vec, b_vec))
    S0 = jnp.zeros((B, H, N, N), f32)
    _, y = lax.scan(rwkv7_step, S0, xs)
    y = jnp.moveaxis(y, 0, 1)
    mean = jnp.mean(y, axis=-1, keepdims=True)
    var = jnp.mean((y - mean) ** 2, axis=-1, keepdims=True)
    yn = ((y - mean) * lax.rsqrt(var + GN_EPS)).reshape(B, T, RWKV_WIDTH)
    yn = yn * gn_w.astype(f32) + gn_b.astype(f32)
    bonus = (jnp.sum(rh * kh * r_k.astype(f32), axis=-1, keepdims=True) * vh).reshape(B, T, RWKV_WIDTH)
    out = (yn + bonus) * jax.nn.silu(g.astype(f32))
    return out.astype(shifted.dtype)


def swa_sink_attention(q, k, v, g, sinks):
    B, T, _ = q.shape
    NB = T // BLOCK
    f32 = jnp.float32
    qb = q.reshape(B, NB, BLOCK, ATTN_KV_HEADS, GQA_GROUP, HEAD_DIM)
    kb = k.reshape(B, NB, BLOCK, ATTN_KV_HEADS, HEAD_DIM)
    vb = v.reshape(B, NB, BLOCK, ATTN_KV_HEADS, HEAD_DIM)
    pad = ((0, 0), (1, 0), (0, 0), (0, 0), (0, 0))
    kw = jnp.concatenate([jnp.pad(kb[:, :-1], pad), kb], axis=2)
    vw = jnp.concatenate([jnp.pad(vb[:, :-1], pad), vb], axis=2)
    scale = HEAD_DIM ** -0.5
    s = jnp.einsum('bnqkgd,bnskd->bnkgqs', qb, kw, preferred_element_type=f32) * scale
    qi = jnp.arange(BLOCK)[:, None]
    si = jnp.arange(2 * BLOCK)[None, :]
    band = (si > qi) & (si <= qi + BLOCK)
    valid = (jnp.arange(NB)[:, None, None] > 0) | (si[None] >= BLOCK)
    mask = (band[None] & valid)[None, :, None, None]
    s = jnp.where(mask, s, -jnp.inf)
    sink = sinks.astype(f32).reshape(ATTN_KV_HEADS, GQA_GROUP)[None, None, :, :, None, None]
    m = jnp.maximum(jnp.max(s, axis=-1, keepdims=True), sink)
    p = jnp.exp(s - m)
    denom = jnp.sum(p, axis=-1, keepdims=True) + jnp.exp(sink - m)
    p = p / denom
    o = jnp.einsum('bnkgqs,bnskd->bnqkgd', p, vw.astype(f32)).reshape(B, T, ATTN_WIDTH)
    return (o * jax.nn.silu(g.astype(f32))).astype(q.dtype)


def setup_inputs(seed: int = 0) -> dict:
    key = jax.random.key(seed)
    ks = jax.random.split(key, 18)
    f32 = jnp.float32
    nrm = lambda k, shape, s: jax.random.normal(k, shape, f32) * s
    return {
        "x": jax.random.normal(ks[0], (BATCH, SEQ, D_MODEL), f32),
        "norm_gain": 1.0 + nrm(ks[1], (DEPTH, D_MODEL), 0.02),
        "w_in": nrm(ks[2], (DEPTH, D_MODEL, IN_WIDTH), D_MODEL ** -0.5),
        "shift_mu": jax.random.uniform(ks[3], (DEPTH, SHIFT_WIDTH), f32),
        "w0": jax.random.uniform(ks[4], (DEPTH, RWKV_WIDTH), f32, minval=-6.0, maxval=0.0),
        "w_up": nrm(ks[5], (DEPTH, DECAY_LORA, RWKV_WIDTH), 0.5 * DECAY_LORA ** -0.5),
        "a0": nrm(ks[6], (DEPTH, RWKV_WIDTH), 0.1),
        "a_up": nrm(ks[7], (DEPTH, ICLR_LORA, RWKV_WIDTH), 0.5 * ICLR_LORA ** -0.5),
        "k_k": 0.85 + nrm(ks[8], (DEPTH, RWKV_WIDTH), 0.02),
        "k_a": 1.0 + nrm(ks[9], (DEPTH, RWKV_WIDTH), 0.02),
        "r_k": nrm(ks[10], (DEPTH, RWKV_HEADS, HEAD_DIM), 0.1),
        "gn_w": 1.0 + nrm(ks[11], (DEPTH, RWKV_WIDTH), 0.02),
        "gn_b": nrm(ks[12], (DEPTH, RWKV_WIDTH), 0.02),
        "sinks": nrm(ks[13], (DEPTH, ATTN_Q_HEADS), 1.0),
        "w_out": nrm(ks[14], (DEPTH, D_MODEL, D_MODEL), D_MODEL ** -0.5),
        "final_gain": 1.0 + nrm(ks[15], (D_MODEL,), 0.02),
    }


def reference(x, norm_gain, w_in, shift_mu, w0, w_up, a0, a_up, k_k, k_a, r_k, gn_w, gn_b, sinks, w_out, final_gain):
    splits = np.cumsum([SHIFT_WIDTH, RWKV_WIDTH, ATTN_WIDTH, KV_WIDTH, KV_WIDTH]).tolist()
    for l in range(DEPTH):
        h = rmsnorm(x, norm_gain[l])
        proj = h @ w_in[l]
        p_shift, g_rwkv, q, k_att, v_att, g_attn = jnp.split(proj, splits, axis=-1)
        shifted = token_shift(p_shift, shift_mu[l])
        y_a = rwkv7_mix(shifted, g_rwkv, w0[l], w_up[l], a0[l], a_up[l], k_k[l], k_a[l], r_k[l], gn_w[l], gn_b[l])
        y_b = swa_sink_attention(q, k_att, v_att, g_attn, sinks[l])
        y = jnp.concatenate([y_a, y_b], axis=-1) @ w_out[l]
        x = x + y
    return rmsnorm(x, final_gain)
```

```cpp
#include <hip/hip_runtime.h>
#include <hip/hip_cooperative_groups.h>
#include <cstdio>
#include <cstdint>
namespace cg = cooperative_groups;

#ifndef MULTI_LAUNCH
#define MULTI_LAUNCH 0
#endif

typedef unsigned short u16;
typedef short bf16x8 __attribute__((ext_vector_type(8)));
typedef float f32x4 __attribute__((ext_vector_type(4)));

#define SEQ 8192
#define NTOK 32768
#define DM 1024
#define INW 3456
#define SHW 1664
#define RW 1792
#define C_R 0
#define C_K 512
#define C_V 1024
#define C_WD 1536
#define C_AD 1600
#define R_G 0
#define R_Q 512
#define R_KA 1024
#define R_GA 1280
#define SCN ((size_t)NTOK * 512)
#define SMEM_BYTES 66560
#define NPHASE 17

struct Params {
  const float *x, *norm_gain, *w_in, *shift_mu, *w0, *w_up, *a0, *a_up, *k_k, *k_a, *r_k, *gn_w, *gn_b, *sinks, *w_out, *final_gain;
  float* out;
  unsigned* bar;
  u16 *WinT, *WoutT, *WupT, *AupT, *h, *projS, *projR, *vT, *sc;
  float *yraw, *rk, *exg;
  u16* exy0;
  int never; int pad;
};

typedef float f32x2_t __attribute__((ext_vector_type(2)));
typedef __bf16 bf16x2_t __attribute__((ext_vector_type(2)));
__device__ __forceinline__ unsigned pk_bf16(float lo, float hi) {
  f32x2_t v = {lo, hi};
  bf16x2_t b = __builtin_convertvector(v, bf16x2_t);
  return __builtin_bit_cast(unsigned, b);
}
__device__ __forceinline__ u16 f2bf(float f) { return (u16)(pk_bf16(f, 0.f) & 0xffffu); }
__device__ __forceinline__ float bf_lo(unsigned u) { return __uint_as_float(u << 16); }
__device__ __forceinline__ float bf_hi(unsigned u) { return __uint_as_float(u & 0xffff0000u); }
__device__ __forceinline__ float sigmoidf_(float x) { return __builtin_amdgcn_rcpf(1.0f + __expf(-x)); }
__device__ __forceinline__ float siluf_(float x) { return x * __builtin_amdgcn_rcpf(1.0f + __expf(-x)); }
__device__ __forceinline__ float tanhf_(float x) { float t = __expf(2.0f * x); return 1.0f - 2.0f * __builtin_amdgcn_rcpf(t + 1.0f); }
template <int CTRL> __device__ __forceinline__ float dpp_mov(float x) {
  return __int_as_float(__builtin_amdgcn_update_dpp(0, __float_as_int(x), CTRL, 0xf, 0xf, false));
}
__device__ __forceinline__ float row16_sum(float x) {
  x += dpp_mov<0xB1>(x);
  x += dpp_mov<0x4E>(x);
  x += dpp_mov<0x141>(x);
  x += dpp_mov<0x140>(x);
  return x;
}
__device__ __forceinline__ float wave_sum(float x) {
#pragma unroll
  for (int o = 32; o > 0; o >>= 1) x += __shfl_xor(x, o);
  return x;
}

typedef unsigned u32x4 __attribute__((ext_vector_type(4)));
typedef unsigned u32x2 __attribute__((ext_vector_type(2)));
__device__ __forceinline__ u32x2 gload8_async(const void* ptr) {
  u32x2 r; asm volatile("global_load_dwordx2 %0, %1, off" : "=v"(r) : "v"(ptr) : "memory"); return r;
}
__device__ __forceinline__ u32x4 gload16_async(const void* ptr) {
  u32x4 r; asm volatile("global_load_dwordx4 %0, %1, off" : "=v"(r) : "v"(ptr) : "memory"); return r;
}
#define XB_TMO      128
#define XB_XCNT(j)  (256  + 64 * (j))
#define XB_XSUB(j)  (1280 + 64 * (j))
#define XB_XGEN(j)  (2304 + 64 * (j))
#define XB_TOP      3328
#define XB_TOPGEN   3392
#define XCD_BAR_WORDS 3456
#define XB_SPIN_CAP (1u << 22)
__device__ __forceinline__ unsigned xb_ld(unsigned* p)              { return __hip_atomic_load(p, __ATOMIC_RELAXED, __HIP_MEMORY_SCOPE_AGENT); }
__device__ __forceinline__ unsigned xb_add(unsigned* p, unsigned v) { return __hip_atomic_fetch_add(p, v, __ATOMIC_RELAXED, __HIP_MEMORY_SCOPE_AGENT); }
__device__ __forceinline__ unsigned xb_xcc_id() { return (unsigned)__builtin_amdgcn_s_getreg((3 << 11) | 20) & 0xFu; }
#define XB_SPIN(cond, bar) do { unsigned _sp = 0; while (cond) { __builtin_amdgcn_s_sleep(1); \
    if ((++_sp & 255u) == 0u) { if (xb_ld(&(bar)[XB_TMO])) break; if (_sp > XB_SPIN_CAP) { atomicAdd(&(bar)[XB_TMO], 1u); break; } } } } while (0)
__device__ __forceinline__ void xcd_barrier_complete(unsigned* bar, unsigned x, unsigned& nloc, unsigned& nx) {
  const unsigned G = gridDim.x;
  unsigned sum, cnt, mine, sp = 0u;
  for (;;) {
    sum = 0u; cnt = 0u; mine = 0u;
#pragma unroll
    for (unsigned j = 0; j < 16; ++j) { const unsigned c = xb_ld(&bar[XB_XCNT(j)]); sum += c; cnt += (c > 0u) ? 1u : 0u; mine = (j == x) ? c : mine; }
    if (sum == G) break;
    __builtin_amdgcn_s_sleep(1);
    if ((++sp & 255u) == 0u) { if (xb_ld(&bar[XB_TMO])) break; if (sp > XB_SPIN_CAP) { atomicAdd(&bar[XB_TMO], 1u); break; } }
  }
  nloc = mine > 0u ? mine : 1u; nx = cnt > 0u ? cnt : 1u;
}
__device__ __forceinline__ void grid_barrier(unsigned* bar, unsigned x, volatile unsigned* st) {
  asm volatile("s_waitcnt vmcnt(0)" ::: "memory");
  __syncthreads();
  if (threadIdx.x == 0) {
    __builtin_amdgcn_s_waitcnt(0);
    unsigned nloc = st[0], nx = st[1];
    if (nloc == 0u) { xcd_barrier_complete(bar, x, nloc, nx); st[0] = nloc; st[1] = nx; }
    const unsigned old = xb_add(&bar[XB_XSUB(x)], 1u);
    const unsigned gen = old / nloc;
    if (old + 1u == (gen + 1u) * nloc) {
      __builtin_amdgcn_fence(__ATOMIC_RELEASE, "agent");
      asm volatile("s_waitcnt vmcnt(0)" ::: "memory");
      const unsigned og = xb_add(&bar[XB_TOP], 1u);
      const unsigned tg = og / nx;
      if (og + 1u == (tg + 1u) * nx) xb_add(&bar[XB_TOPGEN], 1u);
      else XB_SPIN(xb_ld(&bar[XB_TOPGEN]) == tg, bar);
      __builtin_amdgcn_fence(__ATOMIC_ACQUIRE, "agent");
      xb_add(&bar[XB_XGEN(x)], 1u);
      asm volatile("s_waitcnt vmcnt(0)" ::: "memory");
    } else {
      XB_SPIN(xb_ld(&bar[XB_XGEN(x)]) == gen, bar);
      __builtin_amdgcn_fence(__ATOMIC_ACQUIRE, "agent");
      asm volatile("s_waitcnt vmcnt(0)" ::: "memory");
    }
  }
  __syncthreads();
}

__device__ void transpose_tile(const float* __restrict__ src, int ld_src, u16* __restrict__ dst, int ld_dst, int k0, int n0, float* tile, bool perm) {
  const int tid = threadIdx.x;
  {
    const int r0 = tid >> 4, c4 = (tid & 15) * 4;
#pragma unroll
    for (int i = 0; i < 4; ++i) {
      const int r = r0 + 16 * i;
      const f32x4 v = *(const f32x4*)(src + (size_t)(k0 + r) * ld_src + n0 + c4);
      tile[r * 65 + c4] = v[0]; tile[r * 65 + c4 + 1] = v[1]; tile[r * 65 + c4 + 2] = v[2]; tile[r * 65 + c4 + 3] = v[3];
    }
  }
  __syncthreads();
  {
    const int k8 = (tid & 7) * 8;
#pragma unroll
    for (int i = 0; i < 2; ++i) {
      const int nn = (tid >> 3) + 32 * i;
      const int col = perm ? (((nn & 15) >> 2) * 16 + (nn >> 4) * 4 + (nn & 3)) : nn;
      unsigned w[4];
#pragma unroll
      for (int e = 0; e < 4; ++e) w[e] = pk_bf16(tile[(k8 + 2 * e) * 65 + col], tile[(k8 + 2 * e + 1) * 65 + col]);
      *(uint4*)(dst + (size_t)(n0 + nn) * ld_dst + k0 + k8) = make_uint4(w[0], w[1], w[2], w[3]);
    }
  }
  __syncthreads();
}

__device__ void norm_rows_bf16(const float* __restrict__ src, const float* __restrict__ gain, u16* __restrict__ dst) {
  const int lane = threadIdx.x & 63;
  const int gw = blockIdx.x * 4 + (threadIdx.x >> 6), nw = gridDim.x * 4;
  f32x4 g[4];
#pragma unroll
  for (int i = 0; i < 4; ++i) g[i] = *(const f32x4*)(gain + i * 256 + lane * 4);
  for (int row = gw; row < NTOK; row += nw) {
    const float* s = src + (size_t)row * DM;
    f32x4 v[4]; float ss = 0.f;
#pragma unroll
    for (int i = 0; i < 4; ++i) { v[i] = *(const f32x4*)(s + i * 256 + lane * 4); ss += v[i][0] * v[i][0] + v[i][1] * v[i][1] + v[i][2] * v[i][2] + v[i][3] * v[i][3]; }
    ss = wave_sum(ss);
    const float rstd = rsqrtf(ss * (1.0f / DM) + 1e-5f);
#pragma unroll
    for (int i = 0; i < 4; ++i) {
      uint2 o; o.x = pk_bf16(v[i][0] * rstd * g[i][0], v[i][1] * rstd * g[i][1]); o.y = pk_bf16(v[i][2] * rstd * g[i][2], v[i][3] * rstd * g[i][3]);
      *(uint2*)(dst + (size_t)row * DM + i * 256 + lane * 4) = o;
    }
  }
}

__device__ void norm_rows_f32_inplace(float* __restrict__ buf, const float* __restrict__ gain) {
  const int lane = threadIdx.x & 63;
  const int gw = blockIdx.x * 4 + (threadIdx.x >> 6), nw = gridDim.x * 4;
  f32x4 g[4];
#pragma unroll
  for (int i = 0; i < 4; ++i) g[i] = *(const f32x4*)(gain + i * 256 + lane * 4);
  for (int row = gw; row < NTOK; row += nw) {
    float* s = buf + (size_t)row * DM;
    f32x4 v[4]; float ss = 0.f;
#pragma unroll
    for (int i = 0; i < 4; ++i) { v[i] = *(const f32x4*)(s + i * 256 + lane * 4); ss += v[i][0] * v[i][0] + v[i][1] * v[i][1] + v[i][2] * v[i][2] + v[i][3] * v[i][3]; }
    ss = wave_sum(ss);
    const float rstd = rsqrtf(ss * (1.0f / DM) + 1e-5f);
#pragma unroll
    for (int i = 0; i < 4; ++i) { f32x4 o = v[i] * rstd * g[i]; *(f32x4*)(s + i * 256 + lane * 4) = o; }
  }
}

__device__ __forceinline__ void weight_jobs(const Params& p, int l, int vb, int nvb, char* smem) {
  float* tile = (float*)smem;
  const int J_WIN = 16 * 54, J_WOUT = 16 * 16, J_UP = 8;
  const int total = J_WIN + J_WOUT + 2 * J_UP;
  for (int job = vb; job < total; job += nvb) {
    if (job < J_WIN) {
      int kt = job / 54, nt = job % 54;
      transpose_tile(p.w_in + (size_t)l * DM * INW, INW, p.WinT + (size_t)l * INW * DM, DM, kt * 64, nt * 64, tile, true);
    } else if (job < J_WIN + J_WOUT) {
      int r = job - J_WIN; int kt = r / 16, nt = r % 16;
      transpose_tile(p.w_out + (size_t)l * DM * DM, DM, p.WoutT + (size_t)l * DM * DM, DM, kt * 64, nt * 64, tile, true);
    } else if (job < J_WIN + J_WOUT + J_UP) {
      int nt = job - J_WIN - J_WOUT;
      transpose_tile(p.w_up + (size_t)l * 64 * 512, 512, p.WupT + (size_t)l * 512 * 64, 64, 0, nt * 64, tile, false);
    } else {
      int nt = job - J_WIN - J_WOUT - J_UP;
      transpose_tile(p.a_up + (size_t)l * 64 * 512, 512, p.AupT + (size_t)l * 512 * 64, 64, 0, nt * 64, tile, false);
    }
  }
}
__device__ __forceinline__ void phase0(const Params& p, char* smem) {
  weight_jobs(p, 0, blockIdx.x, gridDim.x, smem);
  if (gridDim.x <= 64) { }
  norm_rows_bf16(p.x, p.norm_gain, p.h);
}

template <int MODE, bool SWAP>
__device__ __forceinline__ void gemm_tile(const Params& p, const u16* __restrict__ A, const u16* __restrict__ Bt, const float* __restrict__ xold, int m0, int n0, char* smem,
                                          bool staged, bool has_next, int nm0, int nn0) {
  const int tid = threadIdx.x, lane = tid & 63, wid = tid >> 6, wr = wid >> 1, wc = wid & 1, fr = lane & 15, fq = lane >> 4;
  f32x4 acc[4][4];
#pragma unroll
  for (int i = 0; i < 4; ++i)
#pragma unroll
    for (int j = 0; j < 4; ++j) acc[i][j] = (f32x4){0.f, 0.f, 0.f, 0.f};
  const int r8 = lane >> 3, cs = lane & 7;
  const int frsw = (fr >> 1) & 7;
  const u16* gA[4]; const u16* gB[4];
#pragma unroll
  for (int i = 0; i < 4; ++i) {
    const int row = wid * 32 + i * 8 + r8;
    const int c = cs ^ ((row >> 1) & 7);
    gA[i] = A + (size_t)(m0 + row) * DM + c * 8;
    gB[i] = Bt + (size_t)(n0 + row) * DM + c * 8;
  }
  char* lds_w = smem + wid * 4096 + lane * 16;
#define GEMM_STAGE(BUF, KT) { _Pragma("unroll") for (int i = 0; i < 4; ++i) { \
      __builtin_amdgcn_global_load_lds((const unsigned*)(gA[i] + (KT) * 64), (__attribute__((address_space(3))) unsigned*)(lds_w + (BUF) * 32768 + i * 1024), 16, 0, 0); \
      __builtin_amdgcn_global_load_lds((const unsigned*)(gB[i] + (KT) * 64), (__attribute__((address_space(3))) unsigned*)(lds_w + (BUF) * 32768 + 16384 + i * 1024), 16, 0, 0); } }
  if (!staged) GEMM_STAGE(0, 0)
  asm volatile("s_waitcnt vmcnt(0)" ::: "memory");
  __syncthreads();
  const unsigned lds0 = (unsigned)(size_t)(__attribute__((address_space(3))) char*)smem;
  const unsigned a_rd = lds0 + (wr * 64 + fr) * 128, b_rd = lds0 + 16384 + (wc * 64 + fr) * 128;
  const unsigned cof0 = ((0 * 4 + fq) ^ frsw) << 4, cof1 = ((1 * 4 + fq) ^ frsw) << 4;
#define DS_RD(DST, ADDR, OFF) asm volatile("ds_read_b128 %0, %1 offset:" #OFF : "=v"(DST) : "v"(ADDR))
#define WAIT_LGKM_TIED(N, F) asm volatile("s_waitcnt lgkmcnt(" #N ")" : "+v"(F##a[0]), "+v"(F##a[1]), "+v"(F##a[2]), "+v"(F##a[3]), "+v"(F##b[0]), "+v"(F##b[1]), "+v"(F##b[2]), "+v"(F##b[3]))
  for (int kt = 0; kt < 16; ++kt) {
    if (kt < 15) GEMM_STAGE((kt + 1) & 1, kt + 1)
    else if (has_next) {
#pragma unroll
      for (int i = 0; i < 4; ++i) {
        const int row = wid * 32 + i * 8 + r8;
        const int c = cs ^ ((row >> 1) & 7);
        __builtin_amdgcn_global_load_lds((const unsigned*)(A + (size_t)(nm0 + row) * DM + c * 8), (__attribute__((address_space(3))) unsigned*)(lds_w + i * 1024), 16, 0, 0);
        __builtin_amdgcn_global_load_lds((const unsigned*)(Bt + (size_t)(nn0 + row) * DM + c * 8), (__attribute__((address_space(3))) unsigned*)(lds_w + 16384 + i * 1024), 16, 0, 0);
      }
    }
    const unsigned bo = (kt & 1) * 32768;
    bf16x8 f0a[4], f0b[4], f1a[4], f1b[4];
    {
      const unsigned aa0 = a_rd + bo + cof0, ab0 = b_rd + bo + cof0, aa1 = a_rd + bo + cof1, ab1 = b_rd + bo + cof1;
      DS_RD(f0a[0], aa0, 0); DS_RD(f0a[1], aa0, 2048); DS_RD(f0a[2], aa0, 4096); DS_RD(f0a[3], aa0, 6144);
      DS_RD(f0b[0], ab0, 0); DS_RD(f0b[1], ab0, 2048); DS_RD(f0b[2], ab0, 4096); DS_RD(f0b[3], ab0, 6144);
      DS_RD(f1a[0], aa1, 0); DS_RD(f1a[1], aa1, 2048); DS_RD(f1a[2], aa1, 4096); DS_RD(f1a[3], aa1, 6144);
      DS_RD(f1b[0], ab1, 0); DS_RD(f1b[1], ab1, 2048); DS_RD(f1b[2], ab1, 4096); DS_RD(f1b[3], ab1, 6144);
    }
    WAIT_LGKM_TIED(8, f0);
#pragma unroll
    for (int mi = 0; mi < 4; ++mi)
#pragma unroll
      for (int ni = 0; ni < 4; ++ni) {
        if (SWAP) acc[mi][ni] = __builtin_amdgcn_mfma_f32_16x16x32_bf16(f0a[mi], f0b[ni], acc[mi][ni], 0, 0, 0);
        else      acc[mi][ni] = __builtin_amdgcn_mfma_f32_16x16x32_bf16(f0b[ni], f0a[mi], acc[mi][ni], 0, 0, 0);
      }
    WAIT_LGKM_TIED(0, f1);
#pragma unroll
    for (int mi = 0; mi < 4; ++mi)
#pragma unroll
      for (int ni = 0; ni < 4; ++ni) {
        if (SWAP) acc[mi][ni] = __builtin_amdgcn_mfma_f32_16x16x32_bf16(f1a[mi], f1b[ni], acc[mi][ni], 0, 0, 0);
        else      acc[mi][ni] = __builtin_amdgcn_mfma_f32_16x16x32_bf16(f1b[ni], f1a[mi], acc[mi][ni], 0, 0, 0);
      }
    if (kt < 15) {
      asm volatile("s_waitcnt vmcnt(0)" : "+v"(acc[0][0]), "+v"(acc[0][1]), "+v"(acc[0][2]), "+v"(acc[0][3]), "+v"(acc[1][0]), "+v"(acc[1][1]), "+v"(acc[1][2]), "+v"(acc[1][3]),
                   "+v"(acc[2][0]), "+v"(acc[2][1]), "+v"(acc[2][2]), "+v"(acc[2][3]), "+v"(acc[3][0]), "+v"(acc[3][1]), "+v"(acc[3][2]), "+v"(acc[3][3]) :: "memory");
      __syncthreads();
    }
  }
  if (MODE == 1) {
    if (!SWAP) {
      u16* base; int ld, nb;
      if (n0 < SHW) { base = p.projS; ld = SHW; nb = n0; } else { base = p.projR; ld = RW; nb = n0 - SHW; }
#pragma unroll
      for (int mi = 0; mi < 4; ++mi) {
        const int m = m0 + wr * 64 + mi * 16 + fr;
#pragma unroll
        for (int hp = 0; hp < 2; ++hp) {
          const int n = nb + wc * 64 + fq * 16 + hp * 8;
          uint4 o; o.x = pk_bf16(acc[mi][2 * hp][0], acc[mi][2 * hp][1]); o.y = pk_bf16(acc[mi][2 * hp][2], acc[mi][2 * hp][3]);
          o.z = pk_bf16(acc[mi][2 * hp + 1][0], acc[mi][2 * hp + 1][1]); o.w = pk_bf16(acc[mi][2 * hp + 1][2], acc[mi][2 * hp + 1][3]);
          *(uint4*)(base + (size_t)m * ld + n) = o;
        }
      }
    } else {
      const int b = m0 >> 13;
#pragma unroll
      for (int mi = 0; mi < 4; ++mi) {
        const int t = (m0 & (SEQ - 1)) + wr * 64 + mi * 16 + fq * 4;
#pragma unroll
        for (int ni = 0; ni < 4; ++ni) {
          const int nn = wc * 64 + (fr >> 2) * 16 + ni * 4 + (fr & 3);
          uint2 o; o.x = pk_bf16(acc[mi][ni][0], acc[mi][ni][1]); o.y = pk_bf16(acc[mi][ni][2], acc[mi][ni][3]);
          *(uint2*)(p.vT + ((size_t)(b * 128 + nn)) * SEQ + t) = o;
        }
      }
    }
  } else {
#pragma unroll
    for (int mi = 0; mi < 4; ++mi) {
      const int m = m0 + wr * 64 + mi * 16 + fr;
#pragma unroll
      for (int ni = 0; ni < 4; ++ni) {
        const int n = n0 + wc * 64 + fq * 16 + ni * 4;
        f32x4 xo = *(const f32x4*)(xold + (size_t)m * DM + n);
        *(f32x4*)(p.out + (size_t)m * DM + n) = xo + acc[mi][ni];
      }
    }
  }
}

template <int MODE>
__device__ __forceinline__ void gemm_phase(const Params& p, const u16* A, const u16* Bt, const float* xold, int ntn, char* smem) {
  const int total = 256 * ntn;
  bool staged = false;
  for (int t = blockIdx.x; t < total; t += gridDim.x) {
    const int x = t & 7, i = t >> 3;
    const int mg = i / (8 * ntn), rem = i % (8 * ntn), nt = rem >> 3, mi = rem & 7;
    const int mt = x * 32 + mg * 8 + mi;
    const int t2 = t + gridDim.x;
    const bool has_next = t2 < total;
    const int i2 = t2 >> 3, mg2 = i2 / (8 * ntn), rem2 = i2 % (8 * ntn);
    const int nm0 = ((t2 & 7) * 32 + mg2 * 8 + (rem2 & 7)) * 128, nn0 = (rem2 >> 3) * 128;
    if (MODE == 1 && nt == 22) gemm_tile<MODE, true>(p, A, Bt, xold, mt * 128, nt * 128, smem, staged, has_next, nm0, nn0);
    else gemm_tile<MODE, false>(p, A, Bt, xold, mt * 128, nt * 128, smem, staged, has_next, nm0, nn0);
    staged = has_next;
  }
  asm volatile("s_waitcnt vmcnt(0)" ::: "memory");
  __syncthreads();
}

__device__ __forceinline__ void prep_phase(const Params& p, int l, char* smem) {
  const int tid = threadIdx.x, lane = tid & 63, wid = tid >> 6, fr = lane & 15, fq = lane >> 4;
  const float* mu = p.shift_mu + l * SHW;
  const u16* wupT = p.WupT + (size_t)l * 512 * 64;
  const u16* aupT = p.AupT + (size_t)l * 512 * 64;
  const float* w0 = p.w0 + l * 512; const float* a0 = p.a0 + l * 512;
  const float* kkw = p.k_k + l * 512; const float* kaw = p.k_a + l * 512; const float* rkw = p.r_k + l * 512;
  u16* s_nkk = p.sc; u16* s_e = p.sc + SCN; u16* s_b = p.sc + 2 * SCN; u16* s_kp = p.sc + 3 * SCN; u16* s_r = p.sc + 4 * SCN; u16* s_v = p.sc + 5 * SCN;
  for (int tile = blockIdx.x; tile < 512; tile += gridDim.x) {
    const int tok0 = tile * 64;
    {
      const int tk = tid >> 2, part = tid & 3;
      const int tok = tok0 + tk;
      const bool first = (tok & (SEQ - 1)) == 0;
      const u16* cur = p.projS + (size_t)tok * SHW;
#pragma unroll
      for (int which = 0; which < 2; ++which) {
        const int col = (which ? C_AD : C_WD) + part * 16;
        uint4 c0 = *(const uint4*)(cur + col), c1 = *(const uint4*)(cur + col + 8);
        uint4 p0 = make_uint4(0, 0, 0, 0), p1 = make_uint4(0, 0, 0, 0);
        if (!first) { p0 = *(const uint4*)(cur - SHW + col); p1 = *(const uint4*)(cur - SHW + col + 8); }
        unsigned cu[8] = {c0.x, c0.y, c0.z, c0.w, c1.x, c1.y, c1.z, c1.w};
        unsigned pu[8] = {p0.x, p0.y, p0.z, p0.w, p1.x, p1.y, p1.z, p1.w};
        unsigned ou[8];
#pragma unroll
        for (int i = 0; i < 8; ++i) {
          float ca = bf_lo(cu[i]), cb = bf_hi(cu[i]), pa = bf_lo(pu[i]), pb = bf_hi(pu[i]);
          float xa = ca + (pa - ca) * mu[col + 2 * i], xb = cb + (pb - cb) * mu[col + 2 * i + 1];
          if (which == 0) { xa = tanhf_(xa); xb = tanhf_(xb); }
          ou[i] = pk_bf16(xa, xb);
        }
        const int sw = (tk >> 1) & 7;
        char* dst = smem + which * 8192 + tk * 128;
        *(uint4*)(dst + (((part * 2) ^ sw) << 4)) = make_uint4(ou[0], ou[1], ou[2], ou[3]);
        *(uint4*)(dst + (((part * 2 + 1) ^ sw) << 4)) = make_uint4(ou[4], ou[5], ou[6], ou[7]);
      }
    }
    __syncthreads();
#pragma unroll 1
    for (int hq = 0; hq < 8; ++hq) {
      const int hh = hq >> 2, mq = hq & 3;
      const int head = wid * 2 + hh;
      f32x4 aw[4][1], aa[4][1];
#pragma unroll
      for (int i = 0; i < 4; ++i) { aw[i][0] = (f32x4){0.f, 0.f, 0.f, 0.f}; aa[i][0] = (f32x4){0.f, 0.f, 0.f, 0.f}; }
#pragma unroll
      for (int ks = 0; ks < 2; ++ks) {
        const int coff = ((ks * 4 + fq) ^ ((fr >> 1) & 7)) << 4;
        const bf16x8 xw = *(const bf16x8*)(smem + (mq * 16 + fr) * 128 + coff);
        const bf16x8 xa = *(const bf16x8*)(smem + 8192 + (mq * 16 + fr) * 128 + coff);
#pragma unroll
        for (int ni = 0; ni < 4; ++ni) {
          const int n = head * 64 + (fr >> 2) * 16 + ni * 4 + (fr & 3);
          const bf16x8 wf = *(const bf16x8*)(wupT + n * 64 + ks * 32 + fq * 8);
          const bf16x8 af = *(const bf16x8*)(aupT + n * 64 + ks * 32 + fq * 8);
          aw[ni][0] = __builtin_amdgcn_mfma_f32_16x16x32_bf16(wf, xw, aw[ni][0], 0, 0, 0);
          aa[ni][0] = __builtin_amdgcn_mfma_f32_16x16x32_bf16(af, xa, aa[ni][0], 0, 0, 0);
        }
      }
#pragma unroll
      for (int mi = 0; mi < 1; ++mi) {
        const int tok = tok0 + mq * 16 + fr;
        const bool first = (tok & (SEQ - 1)) == 0;
        const int b = tok >> 13, t = tok & (SEQ - 1);
        const u16* cur = p.projS + (size_t)tok * SHW;
        const size_t obase = ((size_t)(b * 8 + head) * SEQ + t) * 64;
        float kkv[4][4], al[4][4];
        float ssq = 0.f, rks = 0.f;
#pragma unroll
        for (int hp = 0; hp < 2; ++hp) {
          const int cb8 = head * 64 + fq * 16 + hp * 8;
          const uint4 cr4 = *(const uint4*)(cur + C_R + cb8), ck4 = *(const uint4*)(cur + C_K + cb8), cv4 = *(const uint4*)(cur + C_V + cb8);
          uint4 pr4 = make_uint4(0, 0, 0, 0), pk4 = make_uint4(0, 0, 0, 0), pv4 = make_uint4(0, 0, 0, 0);
          if (!first) { pr4 = *(const uint4*)(cur - SHW + C_R + cb8); pk4 = *(const uint4*)(cur - SHW + C_K + cb8); pv4 = *(const uint4*)(cur - SHW + C_V + cb8); }
          unsigned ro_[4], ko_[4], vo_[4], eo_[4];
#pragma unroll
          for (int q = 0; q < 2; ++q) {
            const int ni = hp * 2 + q, cb = cb8 + q * 4;
            const uint2 cr = q ? make_uint2(cr4.z, cr4.w) : make_uint2(cr4.x, cr4.y), ck = q ? make_uint2(ck4.z, ck4.w) : make_uint2(ck4.x, ck4.y), cv = q ? make_uint2(cv4.z, cv4.w) : make_uint2(cv4.x, cv4.y);
            const uint2 pr = q ? make_uint2(pr4.z, pr4.w) : make_uint2(pr4.x, pr4.y), pk = q ? make_uint2(pk4.z, pk4.w) : make_uint2(pk4.x, pk4.y), pv = q ? make_uint2(pv4.z, pv4.w) : make_uint2(pv4.x, pv4.y);
            const f32x4 mr = *(const f32x4*)(mu + C_R + cb), mk = *(const f32x4*)(mu + C_K + cb), mv = *(const f32x4*)(mu + C_V + cb);
            const f32x4 w0v = *(const f32x4*)(w0 + cb), a0v = *(const f32x4*)(a0 + cb), kkc = *(const f32x4*)(kkw + cb), kac = *(const f32x4*)(kaw + cb), rkc = *(const f32x4*)(rkw + cb);
            float rc[4] = {bf_lo(cr.x), bf_hi(cr.x), bf_lo(cr.y), bf_hi(cr.y)}, rp[4] = {bf_lo(pr.x), bf_hi(pr.x), bf_lo(pr.y), bf_hi(pr.y)};
            float kc[4] = {bf_lo(ck.x), bf_hi(ck.x), bf_lo(ck.y), bf_hi(ck.y)}, kp_[4] = {bf_lo(pk.x), bf_hi(pk.x), bf_lo(pk.y), bf_hi(pk.y)};
            float vc[4] = {bf_lo(cv.x), bf_hi(cv.x), bf_lo(cv.y), bf_hi(cv.y)}, vp[4] = {bf_lo(pv.x), bf_hi(pv.x), bf_lo(pv.y), bf_hi(pv.y)};
            float ro[4], ko[4], vo[4], eo[4];
#pragma unroll
            for (int j = 0; j < 4; ++j) {
              const float r = rc[j] + (rp[j] - rc[j]) * mr[j];
              const float k = kc[j] + (kp_[j] - kc[j]) * mk[j];
              const float v = vc[j] + (vp[j] - vc[j]) * mv[j];
              const float a = sigmoidf_(a0v[j] + aa[ni][mi][j]);
              const float e = 0.60653066f * sigmoidf_(w0v[j] + aw[ni][mi][j]);
              const float kk = k * kkc[j];
              const float kpr = k * (1.0f + (a - 1.0f) * kac[j]);
              ssq += kk * kk; rks += r * kpr * rkc[j];
              kkv[ni][j] = kk; al[ni][j] = a;
              ro[j] = r; ko[j] = kpr; vo[j] = v; eo[j] = e;
            }
            ro_[2 * q] = pk_bf16(ro[0], ro[1]); ro_[2 * q + 1] = pk_bf16(ro[2], ro[3]);
            ko_[2 * q] = pk_bf16(ko[0], ko[1]); ko_[2 * q + 1] = pk_bf16(ko[2], ko[3]);
            vo_[2 * q] = pk_bf16(vo[0], vo[1]); vo_[2 * q + 1] = pk_bf16(vo[2], vo[3]);
            eo_[2 * q] = pk_bf16(eo[0], eo[1]); eo_[2 * q + 1] = pk_bf16(eo[2], eo[3]);
          }
          const size_t o = obase + fq * 16 + hp * 8;
          *(uint4*)(s_r + o) = make_uint4(ro_[0], ro_[1], ro_[2], ro_[3]);
          *(uint4*)(s_kp + o) = make_uint4(ko_[0], ko_[1], ko_[2], ko_[3]);
          *(uint4*)(s_v + o) = make_uint4(vo_[0], vo_[1], vo_[2], vo_[3]);
          *(uint4*)(s_e + o) = make_uint4(eo_[0], eo_[1], eo_[2], eo_[3]);
        }
        ssq += __shfl_xor(ssq, 16); ssq += __shfl_xor(ssq, 32);
        rks += __shfl_xor(rks, 16); rks += __shfl_xor(rks, 32);
        const float inv = 1.0f / fmaxf(sqrtf(ssq), 1e-12f);
#pragma unroll
        for (int hp = 0; hp < 2; ++hp) {
          const size_t o = obase + fq * 16 + hp * 8;
          unsigned nn_[4], bb_[4];
#pragma unroll
          for (int q = 0; q < 2; ++q) {
            const int ni = hp * 2 + q;
            const float n0_ = kkv[ni][0] * inv, n1 = kkv[ni][1] * inv, n2 = kkv[ni][2] * inv, n3 = kkv[ni][3] * inv;
            nn_[2 * q] = pk_bf16(-n0_, -n1); nn_[2 * q + 1] = pk_bf16(-n2, -n3);
            bb_[2 * q] = pk_bf16(n0_ * al[ni][0], n1 * al[ni][1]); bb_[2 * q + 1] = pk_bf16(n2 * al[ni][2], n3 * al[ni][3]);
          }
          *(uint4*)(s_nkk + o) = make_uint4(nn_[0], nn_[1], nn_[2], nn_[3]);
          *(uint4*)(s_b + o) = make_uint4(bb_[0], bb_[1], bb_[2], bb_[3]);
        }
        if (fq == 0) p.rk[(size_t)(b * 8 + head) * SEQ + t] = rks;
      }
    }
    __syncthreads();
  }
}

typedef float f32x2 __attribute__((ext_vector_type(2)));
#define SCH 16
#define NPR 8
#define OPB_F (9 * NPR * 64)
__device__ __forceinline__ f32x2 lo2(f32x4 v) { return (f32x2){v[0], v[1]}; }
__device__ __forceinline__ f32x2 hi2(f32x4 v) { return (f32x2){v[2], v[3]}; }
__device__ void scan_block(const Params& p, int sb, char* smem) {
  const int tid = threadIdx.x, lane = tid & 63, wid = tid >> 6;
  const int bh = sb >> 3, r8 = sb & 7;
  const int b = bh >> 3, head = bh & 7;
  float* opb = (float*)smem;
  float* scb = opb + 2 * OPB_F;
  float* vb = scb + 2 * NPR * 4;
  float* yb = vb + 2 * 8 * SCH;
  const size_t base = (size_t)bh * SEQ * 64;
  constexpr int NCH = SEQ / SCH;
  if (wid < 2) {
    __builtin_amdgcn_s_setprio(3);
    const int rg = lane >> 4, c = lane & 15, rowl = wid * 4 + rg;
    f32x2 S01 = {0.f, 0.f}, S23 = {0.f, 0.f};
    __syncthreads();
    for (int ch = 0; ch < NCH; ++ch) {
      const f32x4* o4 = (const f32x4*)(opb + (ch & 1) * OPB_F) + c;
      const f32x4* s4 = (const f32x4*)(scb + (ch & 1) * NPR * 4);
      const f32x4* v4 = (const f32x4*)(vb + (ch & 1) * 8 * SCH + rowl * SCH);
      float* ypart = yb + (ch & 1) * (SCH * 128) + rowl * 16 + c;
      f32x4 A1 = o4[0 * 128], A2 = o4[1 * 128], R1 = o4[2 * 128], D12 = o4[3 * 128], B1 = o4[4 * 128], K1 = o4[5 * 128], b2 = o4[6 * 128], k2 = o4[7 * 128], r2 = o4[8 * 128], cs = s4[0];
      f32x4 vq[4];
#pragma unroll
      for (int i = 0; i < 4; ++i) vq[i] = v4[i];
#pragma unroll
      for (int j = 0; j < NPR; ++j) {
        const f32x4 A1n = o4[0 * 128 + (j + 1) * 16], A2n = o4[1 * 128 + (j + 1) * 16], R1n = o4[2 * 128 + (j + 1) * 16], D12n = o4[3 * 128 + (j + 1) * 16], B1n = o4[4 * 128 + (j + 1) * 16],
                    K1n = o4[5 * 128 + (j + 1) * 16], b2n = o4[6 * 128 + (j + 1) * 16], k2n = o4[7 * 128 + (j + 1) * 16], r2n = o4[8 * 128 + (j + 1) * 16], csn = s4[j + 1];
        asm volatile("" ::: "memory");
        const float v1 = vq[j >> 1][(2 * j) & 3], v2 = vq[j >> 1][(2 * j + 1) & 3];
        f32x2 t1 = S01 * lo2(A1); t1 = __builtin_elementwise_fma(S23, hi2(A1), t1);
        f32x2 t2 = S01 * lo2(A2); t2 = __builtin_elementwise_fma(S23, hi2(A2), t2);
        f32x2 t3 = S01 * lo2(R1); t3 = __builtin_elementwise_fma(S23, hi2(R1), t3);
        float p1 = t1[0] + t1[1], p2 = t2[0] + t2[1], q1 = t3[0] + t3[1];
        p1 = row16_sum(p1); p2 = row16_sum(p2);
        const float u1 = p1;
        const float u2 = fmaf(u1, cs[0], fmaf(v1, cs[1], p2));
        ypart[(2 * j) * 128] = fmaf(u1, cs[2], fmaf(v1, cs[3], q1));
        const f32x2 u1v = {u1, u1}, v1v = {v1, v1}, u2v = {u2, u2}, v2v = {v2, v2};
        S01 = S01 * lo2(D12); S23 = S23 * hi2(D12);
        S01 = __builtin_elementwise_fma(u1v, lo2(B1), S01); S23 = __builtin_elementwise_fma(u1v, hi2(B1), S23);
        S01 = __builtin_elementwise_fma(v1v, lo2(K1), S01); S23 = __builtin_elementwise_fma(v1v, hi2(K1), S23);
        S01 = __builtin_elementwise_fma(u2v, lo2(b2), S01); S23 = __builtin_elementwise_fma(u2v, hi2(b2), S23);
        S01 = __builtin_elementwise_fma(v2v, lo2(k2), S01); S23 = __builtin_elementwise_fma(v2v, hi2(k2), S23);
        f32x2 t4 = S01 * lo2(r2); t4 = __builtin_elementwise_fma(S23, hi2(r2), t4);
        ypart[(2 * j + 1) * 128] = t4[0] + t4[1];
        A1 = A1n; A2 = A2n; R1 = R1n; D12 = D12n; B1 = B1n; K1 = K1n; b2 = b2n; k2 = k2n; r2 = r2n; cs = csn;
      }
      __syncthreads();
    }
    __builtin_amdgcn_s_setprio(0);
  } else {
    const int ht = tid - 128;
    const int pr = ht >> 4, cg = ht & 15;
    const int st = ht >> 3, vrow = ht & 7;
    const u16* gsrc = p.sc + base + (size_t)(2 * pr) * 64 + 4 * cg;
    const u16* vsrc = p.sc + 5 * SCN + base + (size_t)st * 64 + r8 * 8 + vrow;
    uint2 rg0[10], rg1[10]; u16 rv0, rv1;
#define H_LOAD(R, RV, CH) { _Pragma("unroll") for (int a = 0; a < 5; ++a) { R[2 * a] = *(const uint2*)(gsrc + a * SCN + (size_t)(CH) * (SCH * 64)); R[2 * a + 1] = *(const uint2*)(gsrc + a * SCN + (size_t)(CH) * (SCH * 64) + 64); } RV = vsrc[(size_t)(CH) * (SCH * 64)]; }
#define H_UNPK(U) (f32x4){bf_lo((U).x), bf_hi((U).x), bf_lo((U).y), bf_hi((U).y)}
#define H_CONV(R, RV, BUF) { \
      const f32x4 n1 = H_UNPK(R[0]), n2 = H_UNPK(R[1]), e1 = H_UNPK(R[2]), e2 = H_UNPK(R[3]), b1 = H_UNPK(R[4]), b2_ = H_UNPK(R[5]), k1 = H_UNPK(R[6]), k2_ = H_UNPK(R[7]), r1 = H_UNPK(R[8]), r2_ = H_UNPK(R[9]); \
      const f32x4 d1 = (f32x4){__expf(-e1[0]), __expf(-e1[1]), __expf(-e1[2]), __expf(-e1[3])}, d2 = (f32x4){__expf(-e2[0]), __expf(-e2[1]), __expf(-e2[2]), __expf(-e2[3])}; \
      float* ob = opb + (BUF) * OPB_F + pr * 64 + 4 * cg; \
      *(f32x4*)(ob + 0 * 512) = n1; *(f32x4*)(ob + 1 * 512) = d1 * n2; *(f32x4*)(ob + 2 * 512) = d1 * r1; *(f32x4*)(ob + 3 * 512) = d1 * d2; \
      *(f32x4*)(ob + 4 * 512) = b1 * d2; *(f32x4*)(ob + 5 * 512) = k1 * d2; *(f32x4*)(ob + 6 * 512) = b2_; *(f32x4*)(ob + 7 * 512) = k2_; *(f32x4*)(ob + 8 * 512) = r2_; \
      const f32x4 m0 = b1 * n2, m1 = k1 * n2, m2 = b1 * r1, m3 = k1 * r1; \
      float c0 = (m0[0] + m0[1]) + (m0[2] + m0[3]), c1 = (m1[0] + m1[1]) + (m1[2] + m1[3]), c2 = (m2[0] + m2[1]) + (m2[2] + m2[3]), c3 = (m3[0] + m3[1]) + (m3[2] + m3[3]); \
      c0 = row16_sum(c0); c1 = row16_sum(c1); c2 = row16_sum(c2); c3 = row16_sum(c3); \
      if (cg == 0) *(f32x4*)(scb + (BUF) * NPR * 4 + pr * 4) = (f32x4){c0, c1, c2 * 0.0625f, c3 * 0.0625f}; \
      vb[(BUF) * 8 * SCH + vrow * SCH + st] = __uint_as_float(((unsigned)RV) << 16); }
#define H_YRED(CH) { const f32x4* y4 = (const f32x4*)(yb + ((CH) & 1) * (SCH * 128) + st * 128 + vrow * 16); \
      const f32x4 a_ = y4[0] + y4[1], b_ = y4[2] + y4[3]; const f32x4 c_ = a_ + b_; \
      p.yraw[((size_t)b * SEQ + (size_t)(CH) * SCH + st) * 512 + head * 64 + r8 * 8 + vrow] = (c_[0] + c_[1]) + (c_[2] + c_[3]); }
    H_LOAD(rg0, rv0, 0)
    H_LOAD(rg1, rv1, 1)
    H_CONV(rg0, rv0, 0)
    H_LOAD(rg0, rv0, 2)
    __syncthreads();
    for (int ch = 0; ch < NCH; ch += 2) {
      H_CONV(rg1, rv1, 1)
      if (ch + 3 < NCH) H_LOAD(rg1, rv1, ch + 3)
      if (ch >= 1) H_YRED(ch - 1)
      __syncthreads();
      if (ch + 2 < NCH) H_CONV(rg0, rv0, 0)
      if (ch + 4 < NCH) H_LOAD(rg0, rv0, ch + 4)
      H_YRED(ch)
      __syncthreads();
    }
    H_YRED(NCH - 1)
  }
}


#define CP_LD 68
__device__ __forceinline__ void chunkprep_phase(const Params& p, char* smem, int c_lo, int lg, int vb, int nvb) {
  float* fA = (float*)smem;
  float* fR = fA + 16 * CP_LD;
  float* fB = fR + 16 * CP_LD;
  float* fK = fB + 16 * CP_LD;
  float* fV = fK + 16 * CP_LD;
  float* fG = fV + 16 * CP_LD;
  float* fW = fG + 16 * CP_LD;
  float* fM = fW + 16 * CP_LD;
  float* gL = fM + 4 * 256;
  float* mbuf = gL + 64;
  const int tid = threadIdx.x, lane = tid & 63, wid = tid >> 6;
  const int nitems = 32 << lg, cmask = (1 << lg) - 1;
  int nb = 0, first_item = 0;
  const int lg_ = tid >> 7, lt_ = (tid & 127) >> 3, lj8 = (tid & 7) * 8;
  u32x4 u[3];
  if (vb < nitems) {
    const int bh0 = vb >> lg, c0 = c_lo + (vb & cmask);
    const u16* src0 = p.sc + (size_t)(lg_ * 3) * SCN + ((size_t)bh0 * SEQ + (size_t)c0 * 16) * 64 + lt_ * 64 + lj8;
#pragma unroll
    for (int q = 0; q < 3; ++q) u[q] = gload16_async(src0 + q * SCN);
  }
  for (int idx = vb; idx < nitems; idx += nvb) {
    if (nb == 0) first_item = idx;
    const int bh = idx >> lg, c = c_lo + (idx & cmask);
    const int item = bh * 512 + c;
    const size_t goff = ((size_t)bh * SEQ + (size_t)c * 16) * 64;
    {
      if (idx == vb) asm volatile("s_waitcnt vmcnt(0)" ::: "memory"); else asm volatile("s_waitcnt vmcnt(3)" ::: "memory");
      const int o = lt_ * CP_LD + lj8;
#pragma unroll
      for (int q = 0; q < 3; ++q) {
        float* dst = (lg_ == 0 ? (q == 0 ? fA : q == 1 ? fG : fB) : (q == 0 ? fK : q == 1 ? fR : fV)) + o;
        float f[8] = {bf_lo(u[q][0]), bf_hi(u[q][0]), bf_lo(u[q][1]), bf_hi(u[q][1]), bf_lo(u[q][2]), bf_hi(u[q][2]), bf_lo(u[q][3]), bf_hi(u[q][3])};
        if (q == 1 && lg_ == 0) {
#pragma unroll
          for (int e = 0; e < 8; ++e) f[e] = __expf(-f[e]);
        }
        *(f32x4*)dst = (f32x4){f[0], f[1], f[2], f[3]}; *(f32x4*)(dst + 4) = (f32x4){f[4], f[5], f[6], f[7]};
      }
      const int nidx = idx + nvb;
      if (nidx < nitems) {
        const u16* srcn = p.sc + (size_t)(lg_ * 3) * SCN + ((size_t)(nidx >> lg) * SEQ + (size_t)(c_lo + (nidx & cmask)) * 16) * 64 + lt_ * 64 + lj8;
        asm volatile("" ::: "memory");
#pragma unroll
        for (int q = 0; q < 3; ++q) u[q] = gload16_async(srcn + q * SCN);
      }
    }
    __syncthreads();
    {
      const int j = tid & 63, part = tid >> 6;
      float g[16];
#pragma unroll
      for (int t = 0; t < 16; ++t) g[t] = fG[t * CP_LD + j];
#pragma unroll
      for (int t = 1; t < 16; ++t) g[t] *= g[t - 1];
      float* arr = part == 0 ? fA : part == 1 ? fR : part == 2 ? fB : fK;
#pragma unroll
      for (int t = 0; t < 16; ++t) {
        const float f = part == 0 ? (t == 0 ? 1.0f : g[t > 0 ? t - 1 : 0]) : part == 1 ? g[t] : __builtin_amdgcn_rcpf(g[t]);
        arr[t * CP_LD + j] *= f;
      }
      if (part == 0) gL[j] = g[15];
    }
    __syncthreads();
    {
      const float* xa = (wid < 2 ? fA : fR) + (lane & 15) * CP_LD + (lane >> 4);
      const float* xb = ((wid & 1) ? fK : fB) + (lane & 15) * CP_LD + (lane >> 4);
      f32x4 acc4[4];
#pragma unroll
      for (int c4 = 0; c4 < 4; ++c4) acc4[c4] = (f32x4){0.f, 0.f, 0.f, 0.f};
#pragma unroll
      for (int ks = 0; ks < 16; ++ks) acc4[ks & 3] = __builtin_amdgcn_mfma_f32_16x16x4f32(xa[ks * 4], xb[ks * 4], acc4[ks & 3], 0, 0, 0);
      const f32x4 acc = (acc4[0] + acc4[1]) + (acc4[2] + acc4[3]);
      const int s2 = lane & 15;
#pragma unroll
      for (int r = 0; r < 4; ++r) {
        const int t = (lane >> 4) * 4 + r;
        const bool keep = wid < 2 ? (s2 < t) : (s2 <= t);
        const float mval = keep ? acc[r] : 0.f;
        fM[wid * 256 + t * 16 + s2] = mval;
        if (wid == 0) mbuf[nb * 256 + t * 16 + s2] = mval;
      }
    }
    __syncthreads();
    {
      const int t = tid >> 4, i4 = (tid & 15) * 4;
      f32x4 acc = (f32x4){0.f, 0.f, 0.f, 0.f};
#pragma unroll
      for (int q = 0; q < 4; ++q) {
        const f32x4 m = *(const f32x4*)(fM + 256 + t * 16 + q * 4);
#pragma unroll
        for (int e = 0; e < 4; ++e) acc += m[e] * *(const f32x4*)(fV + (q * 4 + e) * CP_LD + i4);
      }
      *(f32x4*)(fW + t * CP_LD + i4) = acc;
    }
    __syncthreads();
    {
      const int pz = tid;
      const int hs = pz >> 7, ph = pz & 127;
      {
        const int kk = ph >> 6, ln = ph & 63, t = ln & 15, quad = ln >> 4, j = 32 * kk + quad * 4;
        const float* src = (hs ? fR : fA) + t * CP_LD + j;
        const f32x4 x = *(const f32x4*)src, y = *(const f32x4*)(src + 16);
        *(uint4*)(p.sc + hs * SCN + goff + ph * 8) = make_uint4(pk_bf16(x[0], x[1]), pk_bf16(x[2], x[3]), pk_bf16(y[0], y[1]), pk_bf16(y[2], y[3]));
      }
      {
        const int jt = ph >> 5, ln = (ph & 31) * 2, j = jt * 16 + (ln & 15), quad = ln >> 4;
        const float* src = hs ? fK : fB;
        const float g0 = gL[j], g1 = gL[j + 1];
        float q0[4], q1[4];
#pragma unroll
        for (int r = 0; r < 4; ++r) { q0[r] = src[(quad * 4 + r) * CP_LD + j] * g0; q1[r] = src[(quad * 4 + r) * CP_LD + j + 1] * g1; }
        *(uint4*)(p.sc + (2 + hs) * SCN + goff + ph * 8) = make_uint4(pk_bf16(q0[0], q0[1]), pk_bf16(q0[2], q0[3]), pk_bf16(q1[0], q1[1]), pk_bf16(q1[2], q1[3]));
      }
      {
        const int it = ph >> 5, ln = (ph & 31) * 2, i = it * 16 + (ln & 15), quad = ln >> 4;
        const float* src = hs ? fV : fW;
        float q0[4], q1[4];
#pragma unroll
        for (int r = 0; r < 4; ++r) { q0[r] = src[(quad * 4 + r) * CP_LD + i]; q1[r] = src[(quad * 4 + r) * CP_LD + i + 1]; }
        *(uint4*)(p.sc + (4 + hs) * SCN + goff + ph * 8) = make_uint4(pk_bf16(q0[0], q0[1]), pk_bf16(q0[2], q0[3]), pk_bf16(q1[0], q1[1]), pk_bf16(q1[2], q1[3]));
      }
      if (pz < 64) {
        const int t = pz & 15, quad = pz >> 4;
        const f32x4 x = *(const f32x4*)(fM + 2 * 256 + t * 16 + quad * 4), y = *(const f32x4*)(fM + 3 * 256 + t * 16 + quad * 4);
        *(uint4*)(p.exy0 + (size_t)item * 1024 + 512 + pz * 8) = make_uint4(pk_bf16(x[0], x[1]), pk_bf16(x[2], x[3]), pk_bf16(y[0], y[1]), pk_bf16(y[2], y[3]));
      }
      if (tid < 64) p.exg[(size_t)item * 64 + tid] = gL[tid];
    }
    ++nb;
    const bool last = idx + nvb >= nitems;
    if (nb == 16 || last) {
      __syncthreads();
      const int k = wid * 4 + (lane >> 4), cidx = lane & 15;
      if (k < nb) {
        const float* mb = mbuf + k * 256;
        float T_[16];
#pragma unroll
        for (int t = 0; t < 16; ++t) {
          float acc = (t == cidx) ? 1.0f : 0.0f;
#pragma unroll
          for (int q = 0; q < 4; ++q) {
            if (q * 4 < t) {
              const f32x4 m = *(const f32x4*)(mb + t * 16 + q * 4);
#pragma unroll
              for (int e = 0; e < 4; ++e) { const int s2 = q * 4 + e; if (s2 < t) acc = fmaf(m[e], T_[s2], acc); }
            }
          }
          T_[t] = acc;
        }
        float* tb = mbuf + k * 256;
#pragma unroll
        for (int t = 0; t < 16; ++t) tb[t * 16 + cidx] = T_[t];
        asm volatile("s_waitcnt lgkmcnt(0)" ::: "memory");
        const int kidx = first_item + k * nvb;
        u16* dst = p.exy0 + (size_t)((kidx >> lg) * 512 + c_lo + (kidx & cmask)) * 1024;
#pragma unroll
        for (int q = 0; q < 4; ++q) {
          const int lp = q * 16 + cidx, tq = lp & 15, qd = lp >> 4;
          const f32x4 x = *(const f32x4*)(tb + tq * 16 + qd * 4);
          *(uint4*)(dst + lp * 8) = make_uint4(pk_bf16(x[0], x[1]), pk_bf16(x[2], x[3]), 0u, 0u);
        }
      }
      nb = 0;
    }
    __syncthreads();
  }
}

#define CS_SLOT 11520
#define CS_RING 5
#define CS_NCH 512
__device__ __forceinline__ void chunkscan_block(const Params& p, int cb, char* smem, int c_lo, int nchl, f32x4 (&z)[4]) {
  const int tid = threadIdx.x, lane = tid & 63, wid = tid >> 6;
  const int bh = (cb & 7) * 4 + (cb >> 5), it = (cb >> 3) & 3, b = bh >> 3, head = bh & 7;
  if (wid == 0) {
    __builtin_amdgcn_s_setprio(3);
    const int fr = lane & 15, quad = lane >> 4;
    if (c_lo == 0) {
#pragma unroll
      for (int jt = 0; jt < 4; ++jt) z[jt] = (f32x4){0.f, 0.f, 0.f, 0.f};
    }
    u16* yo = (u16*)p.yraw + ((size_t)b * SEQ + (size_t)c_lo * 16 + quad * 4) * 512 + head * 64 + it * 16 + fr;
    asm volatile("s_waitcnt lgkmcnt(0)\n\ts_barrier" ::: "memory");
#define CS_LOADOPS(SL) { const char* sl_ = (SL); \
      af0 = *(const bf16x8*)(sl_ + lane * 16); af1 = *(const bf16x8*)(sl_ + 1024 + lane * 16); \
      rf0 = *(const bf16x8*)(sl_ + 2048 + lane * 16); rf1 = *(const bf16x8*)(sl_ + 3072 + lane * 16); \
      tf = *(const bf16x8*)(sl_ + 9216 + lane * 16); mf = *(const bf16x8*)(sl_ + 10240 + lane * 16); \
      xx = *(const uint2*)(sl_ + 8192 + lane * 8); vv = *(const uint2*)(sl_ + 8704 + lane * 8); \
      _Pragma("unroll") for (int jt = 0; jt < 4; ++jt) { gam[jt] = *(const f32x4*)(sl_ + 11264 + (jt * 16 + quad * 4) * 4); \
        bkl[jt] = *(const uint2*)(sl_ + 4096 + (jt * 64 + lane) * 8); bkh[jt] = *(const uint2*)(sl_ + 6144 + (jt * 64 + lane) * 8); } }
    bf16x8 af0, af1, rf0, rf1, tf, mf; uint2 xx, vv; f32x4 gam[4]; uint2 bkl[4], bkh[4];
    CS_LOADOPS(smem)
    int slot = 1;
    for (int c = 0; c < nchl; ++c) {
      union { unsigned u[4]; bf16x8 v; } zb0, zb1;
      zb0.u[0] = pk_bf16(z[0][0], z[0][1]); zb0.u[1] = pk_bf16(z[0][2], z[0][3]); zb0.u[2] = pk_bf16(z[1][0], z[1][1]); zb0.u[3] = pk_bf16(z[1][2], z[1][3]);
      zb1.u[0] = pk_bf16(z[2][0], z[2][1]); zb1.u[1] = pk_bf16(z[2][2], z[2][3]); zb1.u[2] = pk_bf16(z[3][0], z[3][1]); zb1.u[3] = pk_bf16(z[3][2], z[3][3]);
      f32x4 u0 = (f32x4){bf_lo(xx.x), bf_hi(xx.x), bf_lo(xx.y), bf_hi(xx.y)}, y = (f32x4){0.f, 0.f, 0.f, 0.f};
      u0 = __builtin_amdgcn_mfma_f32_16x16x32_bf16(af0, zb0.v, u0, 0, 0, 0);
      y = __builtin_amdgcn_mfma_f32_16x16x32_bf16(rf0, zb0.v, y, 0, 0, 0);
      u0 = __builtin_amdgcn_mfma_f32_16x16x32_bf16(af1, zb1.v, u0, 0, 0, 0);
      y = __builtin_amdgcn_mfma_f32_16x16x32_bf16(rf1, zb1.v, y, 0, 0, 0);
      union { unsigned u[4]; bf16x8 v; } ub, uv;
      ub.u[0] = pk_bf16(u0[0], u0[1]); ub.u[1] = pk_bf16(u0[2], u0[3]); ub.u[2] = 0u; ub.u[3] = 0u;
      const f32x4 u = __builtin_amdgcn_mfma_f32_16x16x32_bf16(tf, ub.v, (f32x4){0.f, 0.f, 0.f, 0.f}, 0, 0, 0);
      uv.u[0] = pk_bf16(u[0], u[1]); uv.u[1] = pk_bf16(u[2], u[3]); uv.u[2] = vv.x; uv.u[3] = vv.y;
      y = __builtin_amdgcn_mfma_f32_16x16x32_bf16(mf, uv.v, y, 0, 0, 0);
#pragma unroll
      for (int jt = 0; jt < 4; ++jt) {
        union { uint2 h[2]; bf16x8 v; } bk;
        bk.h[0] = bkl[jt]; bk.h[1] = bkh[jt];
        z[jt] = __builtin_amdgcn_mfma_f32_16x16x32_bf16(bk.v, uv.v, z[jt] * gam[jt], 0, 0, 0);
      }
      if (c + 1 < nchl) CS_LOADOPS(smem + slot * CS_SLOT)
      slot = (slot + 1 == CS_RING) ? 0 : slot + 1;
      { const unsigned y01 = pk_bf16(y[0], y[1]), y23 = pk_bf16(y[2], y[3]); yo[0] = (u16)y01; yo[512] = (u16)(y01 >> 16); yo[1024] = (u16)y23; yo[1536] = (u16)(y23 >> 16); }
      yo += 16 * 512;
      asm volatile("s_waitcnt lgkmcnt(0)\n\ts_barrier" ::: "memory");
    }
    __builtin_amdgcn_s_setprio(0);
  } else {
    const int hw = wid - 1;
    const size_t ibase = (size_t)bh * CS_NCH;
#define CS_DMA(SRC, DSTOFF) __builtin_amdgcn_global_load_lds((const unsigned*)(SRC), (__attribute__((address_space(3))) unsigned*)(slot_ + (DSTOFF) + lane * 16), 16, 0, 0)
#define CS_ISSUE(C, SLOT) { const size_t item_ = ibase + (C); const u16* g_ = p.sc + ((size_t)bh * SEQ + (size_t)(C) * 16) * 64 + lane * 8; char* slot_ = smem + (SLOT) * CS_SLOT; \
      if (hw == 0) { CS_DMA(g_ + 0 * SCN, 0); CS_DMA(g_ + 0 * SCN + 512, 1024); CS_DMA(g_ + 2 * SCN, 4096); CS_DMA(p.exy0 + item_ * 1024 + lane * 8, 9216); if (lane < 32) CS_DMA(g_ + 4 * SCN + it * 256, 8192); } \
      else if (hw == 1) { CS_DMA(g_ + 1 * SCN, 2048); CS_DMA(g_ + 1 * SCN + 512, 3072); CS_DMA(g_ + 2 * SCN + 512, 5120); CS_DMA(p.exy0 + item_ * 1024 + 512 + lane * 8, 10240); if (lane < 32) CS_DMA(g_ + 5 * SCN + it * 256, 8704); } \
      else { CS_DMA(g_ + 3 * SCN, 6144); CS_DMA(g_ + 3 * SCN + 512, 7168); if (lane < 16) CS_DMA(p.exg + item_ * 64 + lane * 4, 11264); } }
#define CS_WAITBAR(N5, N3) { if (hw < 2) asm volatile("s_waitcnt vmcnt(" #N5 ")\n\ts_barrier" ::: "memory"); else asm volatile("s_waitcnt vmcnt(" #N3 ")\n\ts_barrier" ::: "memory"); }
    CS_ISSUE(c_lo + 0, 0) CS_ISSUE(c_lo + 1, 1) CS_ISSUE(c_lo + 2, 2) CS_ISSUE(c_lo + 3, 3)
    CS_WAITBAR(10, 6)
    int slot = 4;
    for (int c = 0; c < nchl; ++c) {
      if (c + 4 < nchl) {
        CS_ISSUE(c_lo + c + 4, slot)
        slot = (slot + 1 == CS_RING) ? 0 : slot + 1;
        CS_WAITBAR(10, 6)
      } else {
        const int n = nchl - 3 - c;
        if (n >= 1) CS_WAITBAR(5, 3)
        else CS_WAITBAR(0, 0)
      }
    }
  }
}

__device__ __forceinline__ void attn_items(const Params& p, int l, int vb, int nvb, char* smem) {
  const int tid = threadIdx.x, lane = tid & 63, wid = tid >> 6, fr = lane & 15, fq = lane >> 4;
  char* sK = smem;
  char* sV = smem + 32768;
  u16* ycat = p.h;
  for (int item = vb; item < 2048; item += nvb) {
    const int head = item & 7, blk = (item >> 3) & 63, b = item >> 9, kvh = head >> 2;
    const int t0 = blk * 128;
    __syncthreads();
#pragma unroll
    for (int i = 0; i < 8; ++i) {
      const int id = tid + 256 * i;
      {
        const int key = id >> 3, chk = id & 7;
        const int t = t0 - 128 + key;
        uint4 v = make_uint4(0, 0, 0, 0);
        if (t >= 0) v = *(const uint4*)(p.projR + ((size_t)b * SEQ + t) * RW + R_KA + kvh * 64 + chk * 8);
        *(uint4*)(sK + key * 128 + ((chk ^ ((key >> 1) & 7)) << 4)) = v;
      }
      {
        const int d = id >> 5, chk = id & 31;
        const int t = t0 - 128 + chk * 8;
        uint4 v = make_uint4(0, 0, 0, 0);
        if (t >= 0) v = *(const uint4*)(p.vT + ((size_t)((b * 2 + kvh) * 64 + d)) * SEQ + t);
        *(uint4*)(sV + d * 528 + chk * 16) = v;
      }
    }
    __syncthreads();
    const int q0 = wid * 32;
    bf16x8 qf[2][2];
#pragma unroll
    for (int qt = 0; qt < 2; ++qt)
#pragma unroll
      for (int ks = 0; ks < 2; ++ks)
        qf[qt][ks] = *(const bf16x8*)(p.projR + ((size_t)b * SEQ + t0 + q0 + qt * 16 + fr) * RW + R_Q + head * 64 + ks * 32 + fq * 8);
    f32x4 acc[16][2];
#pragma unroll
    for (int kt = 0; kt < 16; ++kt) { acc[kt][0] = (f32x4){0.f, 0.f, 0.f, 0.f}; acc[kt][1] = (f32x4){0.f, 0.f, 0.f, 0.f}; }
#pragma unroll
    for (int kt = 0; kt < 16; ++kt)
#pragma unroll
      for (int ks = 0; ks < 2; ++ks) {
        const bf16x8 kf = *(const bf16x8*)(sK + (kt * 16 + fr) * 128 + (((ks * 4 + fq) ^ ((fr >> 1) & 7)) << 4));
        acc[kt][0] = __builtin_amdgcn_mfma_f32_16x16x32_bf16(kf, qf[0][ks], acc[kt][0], 0, 0, 0);
        acc[kt][1] = __builtin_amdgcn_mfma_f32_16x16x32_bf16(kf, qf[1][ks], acc[kt][1], 0, 0, 0);
      }
    const float sink = p.sinks[l * 8 + head];
    float inv[2];
#pragma unroll
    for (int qt = 0; qt < 2; ++qt) {
      const int qi = q0 + qt * 16 + fr;
      float m = sink;
#pragma unroll
      for (int kt = 0; kt < 16; ++kt)
#pragma unroll
        for (int j = 0; j < 4; ++j) {
          const int si = kt * 16 + fq * 4 + j;
          const bool ok = (si > qi) && (si <= qi + 128) && (blk > 0 || si >= 128);
          const float s = ok ? acc[kt][qt][j] * 0.125f : -INFINITY;
          acc[kt][qt][j] = s; m = fmaxf(m, s);
        }
      m = fmaxf(m, __shfl_xor(m, 16)); m = fmaxf(m, __shfl_xor(m, 32));
      float sum = 0.f;
#pragma unroll
      for (int kt = 0; kt < 16; ++kt)
#pragma unroll
        for (int j = 0; j < 4; ++j) { const float pv = __expf(acc[kt][qt][j] - m); acc[kt][qt][j] = pv; sum += pv; }
      sum += __shfl_xor(sum, 16); sum += __shfl_xor(sum, 32);
      inv[qt] = 1.0f / (sum + __expf(sink - m));
    }
    f32x4 o[4][2];
#pragma unroll
    for (int dt = 0; dt < 4; ++dt) { o[dt][0] = (f32x4){0.f, 0.f, 0.f, 0.f}; o[dt][1] = (f32x4){0.f, 0.f, 0.f, 0.f}; }
#pragma unroll
    for (int kk = 0; kk < 8; ++kk) {
      bf16x8 pf[2];
#pragma unroll
      for (int qt = 0; qt < 2; ++qt) {
        union { unsigned u[4]; bf16x8 v; } cv;
        cv.u[0] = pk_bf16(acc[2 * kk][qt][0], acc[2 * kk][qt][1]); cv.u[1] = pk_bf16(acc[2 * kk][qt][2], acc[2 * kk][qt][3]);
        cv.u[2] = pk_bf16(acc[2 * kk + 1][qt][0], acc[2 * kk + 1][qt][1]); cv.u[3] = pk_bf16(acc[2 * kk + 1][qt][2], acc[2 * kk + 1][qt][3]);
        pf[qt] = cv.v;
      }
#pragma unroll
      for (int dt = 0; dt < 4; ++dt) {
        union { uint2 h[2]; bf16x8 v; } vv;
        const char* vr = sV + (dt * 16 + fr) * 528 + (kk * 32 + fq * 4) * 2;
        vv.h[0] = *(const uint2*)vr; vv.h[1] = *(const uint2*)(vr + 32);
        o[dt][0] = __builtin_amdgcn_mfma_f32_16x16x32_bf16(vv.v, pf[0], o[dt][0], 0, 0, 0);
        o[dt][1] = __builtin_amdgcn_mfma_f32_16x16x32_bf16(vv.v, pf[1], o[dt][1], 0, 0, 0);
      }
    }
#pragma unroll
    for (int qt = 0; qt < 2; ++qt) {
      const size_t tok = (size_t)b * SEQ + t0 + q0 + qt * 16 + fr;
#pragma unroll
      for (int dt = 0; dt < 4; ++dt) {
        const int d = head * 64 + dt * 16 + fq * 4;
        const uint2 g = *(const uint2*)(p.projR + tok * RW + R_GA + d);
        const float g0 = bf_lo(g.x), g1 = bf_hi(g.x), g2 = bf_lo(g.y), g3 = bf_hi(g.y);
        const float v0 = o[dt][qt][0] * inv[qt] * siluf_(g0), v1 = o[dt][qt][1] * inv[qt] * siluf_(g1);
        const float v2 = o[dt][qt][2] * inv[qt] * siluf_(g2), v3 = o[dt][qt][3] * inv[qt] * siluf_(g3);
        *(uint2*)(ycat + tok * DM + 512 + d) = make_uint2(pk_bf16(v0, v1), pk_bf16(v2, v3));
      }
    }
  }
}

__device__ __forceinline__ void mixA_phase(const Params& p, int l, char* smem, f32x4 (&z)[4]) {
  const int nb = gridDim.x;
  if (nb > 128) {
    if ((int)blockIdx.x < 128) chunkscan_block(p, blockIdx.x, smem, 0, 256, z);
    else {
      chunkprep_phase(p, smem, 256, 8, blockIdx.x - 128, nb - 128);
    }
  } else {
    if (l == 0) weight_jobs(p, 1, blockIdx.x, nb, smem);
    for (int cb = blockIdx.x; cb < 128; cb += nb) { __syncthreads(); f32x4 zl[4]; chunkscan_block(p, cb, smem, 0, 512, zl); }
  }
}
__device__ __forceinline__ void mixB_phase(const Params& p, int l, char* smem, f32x4 (&z)[4]) {
  const int nb = gridDim.x;
  if (nb > 128) {
    if ((int)blockIdx.x < 128) chunkscan_block(p, blockIdx.x, smem, 256, 256, z);
    else {
      if (l == 0) weight_jobs(p, 1, blockIdx.x - 128, nb - 128, smem);
      attn_items(p, l, blockIdx.x - 128, nb - 128, smem);
    }
  } else attn_items(p, l, blockIdx.x, nb, smem);
}

__device__ __forceinline__ void post_phase(const Params& p, int l) {
  const float* gw = p.gn_w + l * 512; const float* gb = p.gn_b + l * 512;
  const u16* s_v = p.sc + 5 * SCN;
  u16* ycat = p.h;
  const int nthreads = gridDim.x * 256;
  for (int idx = blockIdx.x * 256 + threadIdx.x; idx < (NTOK / 4) * 128; idx += nthreads) {
    const int tok = (idx >> 7) * 4, c4 = (idx & 127) * 4, head = c4 >> 6;
    const int b = tok >> 13, t = tok & (SEQ - 1);
    f32x4 y[4];
#pragma unroll
    for (int r = 0; r < 4; ++r) { const uint2 yy = *(const uint2*)((const u16*)p.yraw + (size_t)(tok + r) * 512 + c4); y[r] = (f32x4){bf_lo(yy.x), bf_hi(yy.x), bf_lo(yy.y), bf_hi(yy.y)}; }
    const size_t so = ((size_t)(b * 8 + head) * SEQ + t);
    const u16* vch = s_v + (so & ~(size_t)15) * 64;
    const u16* vp = vch + ((((c4 & 63) >> 4) * 64 + (((t & 15) >> 2) << 4) + (c4 & 15)) * 4);
    uint2 ve[4];
#pragma unroll
    for (int j = 0; j < 4; ++j) ve[j] = *(const uint2*)(vp + j * 4);
    const f32x4 rk4 = *(const f32x4*)(p.rk + so);
    uint2 gg[4];
#pragma unroll
    for (int r = 0; r < 4; ++r) gg[r] = *(const uint2*)(p.projR + (size_t)(tok + r) * RW + R_G + c4);
    const f32x4 gwv = *(const f32x4*)(gw + c4), gbv = *(const f32x4*)(gb + c4);
#pragma unroll
    for (int r = 0; r < 4; ++r) {
      float s = (y[r][0] + y[r][1]) + (y[r][2] + y[r][3]);
      s += __shfl_xor(s, 1); s += __shfl_xor(s, 2); s += __shfl_xor(s, 4); s += __shfl_xor(s, 8);
      const float mean = s * (1.0f / 64.0f);
      const f32x4 d = y[r] - mean;
      float q = d[0] * d[0] + d[1] * d[1] + d[2] * d[2] + d[3] * d[3];
      q += __shfl_xor(q, 1); q += __shfl_xor(q, 2); q += __shfl_xor(q, 4); q += __shfl_xor(q, 8);
      const float rstd = rsqrtf(q * (1.0f / 64.0f) + 64e-5f);
      float v[4];
#pragma unroll
      for (int j = 0; j < 4; ++j) { const unsigned w = (r < 2) ? ve[j].x : ve[j].y; v[j] = (r & 1) ? bf_hi(w) : bf_lo(w); }
      const float g[4] = {bf_lo(gg[r].x), bf_hi(gg[r].x), bf_lo(gg[r].y), bf_hi(gg[r].y)};
      float o[4];
#pragma unroll
      for (int j = 0; j < 4; ++j) o[j] = (d[j] * rstd * gwv[j] + gbv[j] + rk4[r] * v[j]) * siluf_(g[j]);
      *(uint2*)(ycat + (size_t)(tok + r) * DM + c4) = make_uint2(pk_bf16(o[0], o[1]), pk_bf16(o[2], o[3]));
    }
  }
}

__global__ void __launch_bounds__(256, 2) mega(Params p, int ph_begin, int ph_end) {
  __shared__ __attribute__((aligned(16))) char smem[SMEM_BYTES];
  __shared__ __attribute__((aligned(16))) unsigned xb_st[4];
  if (p.never) cg::this_grid().sync();
  const unsigned xcc = xb_xcc_id();
  if (threadIdx.x == 0) { xb_st[0] = 0u; xb_st[1] = 0u; if (ph_end - ph_begin > 1) (void)xb_add(&p.bar[XB_XCNT(xcc)], 1u); }
  __syncthreads();
#define RUN_PHASE(K, STMT) if (ph_begin <= (K) && (K) < ph_end) { STMT; if ((K) + 1 < ph_end) { grid_barrier(p.bar, xcc, xb_st); } }
  const bool split = gridDim.x > 128;
  f32x4 zst[4];
#pragma unroll
  for (int jt = 0; jt < 4; ++jt) zst[jt] = (f32x4){0.f, 0.f, 0.f, 0.f};
  RUN_PHASE(0, phase0(p, smem))
  RUN_PHASE(1, gemm_phase<1>(p, p.h, p.WinT, nullptr, 27, smem))
  RUN_PHASE(2, prep_phase(p, 0, smem))
  RUN_PHASE(3, chunkprep_phase(p, smem, 0, split ? 8 : 9, blockIdx.x, gridDim.x))
  RUN_PHASE(4, mixA_phase(p, 0, smem, zst))
  RUN_PHASE(5, mixB_phase(p, 0, smem, zst))
  RUN_PHASE(6, post_phase(p, 0))
  RUN_PHASE(7, gemm_phase<2>(p, p.h, p.WoutT, p.x, 8, smem))
  RUN_PHASE(8, norm_rows_bf16(p.out, p.norm_gain + DM, p.h))
  RUN_PHASE(9, gemm_phase<1>(p, p.h, p.WinT + (size_t)INW * DM, nullptr, 27, smem))
  RUN_PHASE(10, prep_phase(p, 1, smem))
  RUN_PHASE(11, chunkprep_phase(p, smem, 0, split ? 8 : 9, blockIdx.x, gridDim.x))
  RUN_PHASE(12, mixA_phase(p, 1, smem, zst))
  RUN_PHASE(13, mixB_phase(p, 1, smem, zst))
  RUN_PHASE(14, post_phase(p, 1))
  RUN_PHASE(15, gemm_phase<2>(p, p.h, p.WoutT + (size_t)DM * DM, p.out, 8, smem))
  RUN_PHASE(16, norm_rows_f32_inplace(p.out, p.final_gain))
}

extern "C" void kernel_launch(void* const* d_in, const int* in_sizes, int n_in, void* d_out, int out_size, void* d_ws, size_t ws_size, hipStream_t stream) {
  Params p{};
  p.x = (const float*)d_in[0]; p.norm_gain = (const float*)d_in[1]; p.w_in = (const float*)d_in[2]; p.shift_mu = (const float*)d_in[3];
  p.w0 = (const float*)d_in[4]; p.w_up = (const float*)d_in[5]; p.a0 = (const float*)d_in[6]; p.a_up = (const float*)d_in[7];
  p.k_k = (const float*)d_in[8]; p.k_a = (const float*)d_in[9]; p.r_k = (const float*)d_in[10]; p.gn_w = (const float*)d_in[11];
  p.gn_b = (const float*)d_in[12]; p.sinks = (const float*)d_in[13]; p.w_out = (const float*)d_in[14]; p.final_gain = (const float*)d_in[15];
  p.out = (float*)d_out;
  char* w = (char*)d_ws; size_t off = 0;
  auto take = [&](size_t bytes) { char* r = w + off; off += (bytes + 255) & ~(size_t)255; return r; };
  p.bar = (unsigned*)take(16384);
  p.WinT = (u16*)take((size_t)2 * INW * DM * 2);
  p.WoutT = (u16*)take((size_t)2 * DM * DM * 2);
  p.WupT = (u16*)take((size_t)2 * 512 * 64 * 2);
  p.AupT = (u16*)take((size_t)2 * 512 * 64 * 2);
  p.h = (u16*)take((size_t)NTOK * DM * 2);
  p.projS = (u16*)take((size_t)NTOK * SHW * 2);
  p.yraw = (float*)p.projS;
  p.exy0 = (u16*)((char*)p.projS + (size_t)NTOK * 512 * 4);
  p.exg = (float*)((char*)p.projS + (size_t)NTOK * 512 * 4 + (size_t)16384 * 1024 * 2);
  p.projR = (u16*)take((size_t)NTOK * RW * 2);
  p.vT = (u16*)take((size_t)4 * 2 * 64 * SEQ * 2);
  p.sc = (u16*)take((size_t)6 * SCN * 2);
  p.rk = (float*)take((size_t)NTOK * 8 * 4);
  p.never = 0; p.pad = 0;
  static int grid_blocks = 0;
  if (!grid_blocks) {
    int dev = 0, cus = 0, per_cu = 0;
    hipGetDevice(&dev);
    hipDeviceGetAttribute(&cus, hipDeviceAttributeMultiprocessorCount, dev);
    hipOccupancyMaxActiveBlocksPerMultiprocessor(&per_cu, mega, 256, 0);
    if (per_cu > 2) per_cu = 2;
    if (per_cu < 1) per_cu = 1;
    grid_blocks = cus * per_cu;
  }
  hipMemsetAsync(p.bar, 0, 16384, stream);
#if MULTI_LAUNCH
  for (int ph = 0; ph < NPHASE; ++ph) {
    hipLaunchKernelGGL(mega, dim3(grid_blocks), dim3(256), 0, stream, p, ph, ph + 1);
  }
#else
  int b = 0, e = NPHASE;
  void* args[] = {&p, &b, &e};
  hipError_t err = hipLaunchCooperativeKernel((void*)mega, dim3(grid_blocks), dim3(256), args, 0, stream);
  if (err != hipSuccess) fprintf(stderr, "cooperative launch failed: %s (grid %d)\n", hipGetErrorString(err), grid_blocks);
#endif
}
```

```cpp
#include <hip/hip_runtime.h>
#include <hip/hip_cooperative_groups.h>
#include <cstdio>
#include <cstdint>
namespace cg = cooperative_groups;

#ifndef MULTI_LAUNCH
#define MULTI_LAUNCH 0
#endif

typedef unsigned short u16;
typedef short bf16x8 __attribute__((ext_vector_type(8)));
typedef float f32x4 __attribute__((ext_vector_type(4)));

#define SEQ 8192
#define NTOK 32768
#define DM 1024
#define INW 3456
#define SHW 1664
#define RW 1792
#define C_R 0
#define C_K 512
#define C_V 1024
#define C_WD 1536
#define C_AD 1600
#define R_G 0
#define R_Q 512
#define R_KA 1024
#define R_GA 1280
#define SCN ((size_t)NTOK * 512)
#define SMEM_BYTES 66560
#define NPHASE 17

struct Params {
  const float *x, *norm_gain, *w_in, *shift_mu, *w0, *w_up, *a0, *a_up, *k_k, *k_a, *r_k, *gn_w, *gn_b, *sinks, *w_out, *final_gain;
  float* out;
  unsigned* bar;
  u16 *WinT, *WoutT, *WupT, *AupT, *h, *projS, *projR, *vT, *sc;
  float *yraw, *rk, *exg;
  u16* exy0;
  int never; int pad;
};

typedef float f32x2_t __attribute__((ext_vector_type(2)));
typedef __bf16 bf16x2_t __attribute__((ext_vector_type(2)));
__device__ __forceinline__ unsigned pk_bf16(float lo, float hi) {
  f32x2_t v = {lo, hi};
  bf16x2_t b = __builtin_convertvector(v, bf16x2_t);
  return __builtin_bit_cast(unsigned, b);
}
__device__ __forceinline__ u16 f2bf(float f) { return (u16)(pk_bf16(f, 0.f) & 0xffffu); }
__device__ __forceinline__ float bf_lo(unsigned u) { return __uint_as_float(u << 16); }
__device__ __forceinline__ float bf_hi(unsigned u) { return __uint_as_float(u & 0xffff0000u); }
__device__ __forceinline__ float sigmoidf_(float x) { return __builtin_amdgcn_rcpf(1.0f + __expf(-x)); }
__device__ __forceinline__ float siluf_(float x) { return x * __builtin_amdgcn_rcpf(1.0f + __expf(-x)); }
__device__ __forceinline__ float tanhf_(float x) { float t = __expf(2.0f * x); return 1.0f - 2.0f * __builtin_amdgcn_rcpf(t + 1.0f); }
template <int CTRL> __device__ __forceinline__ float dpp_mov(float x) {
  return __int_as_float(__builtin_amdgcn_update_dpp(0, __float_as_int(x), CTRL, 0xf, 0xf, false));
}
__device__ __forceinline__ float row16_sum(float x) {
  x += dpp_mov<0xB1>(x);
  x += dpp_mov<0x4E>(x);
  x += dpp_mov<0x141>(x);
  x += dpp_mov<0x140>(x);
  return x;
}
__device__ __forceinline__ float wave_sum(float x) {
#pragma unroll
  for (int o = 32; o > 0; o >>= 1) x += __shfl_xor(x, o);
  return x;
}

typedef unsigned u32x4 __attribute__((ext_vector_type(4)));
typedef unsigned u32x2 __attribute__((ext_vector_type(2)));
__device__ __forceinline__ u32x2 gload8_async(const void* ptr) {
  u32x2 r; asm volatile("global_load_dwordx2 %0, %1, off" : "=v"(r) : "v"(ptr) : "memory"); return r;
}
__device__ __forceinline__ u32x4 gload16_async(const void* ptr) {
  u32x4 r; asm volatile("global_load_dwordx4 %0, %1, off" : "=v"(r) : "v"(ptr) : "memory"); return r;
}
#define XB_TMO      128
#define XB_XCNT(j)  (256  + 64 * (j))
#define XB_XSUB(j)  (1280 + 64 * (j))
#define XB_XGEN(j)  (2304 + 64 * (j))
#define XB_TOP      3328
#define XB_TOPGEN   3392
#define XCD_BAR_WORDS 3456
#define XB_SPIN_CAP (1u << 22)
__device__ __forceinline__ unsigned xb_ld(unsigned* p)              { return __hip_atomic_load(p, __ATOMIC_RELAXED, __HIP_MEMORY_SCOPE_AGENT); }
__device__ __forceinline__ unsigned xb_add(unsigned* p, unsigned v) { return __hip_atomic_fetch_add(p, v, __ATOMIC_RELAXED, __HIP_MEMORY_SCOPE_AGENT); }
__device__ __forceinline__ unsigned xb_xcc_id() { return (unsigned)__builtin_amdgcn_s_getreg((3 << 11) | 20) & 0xFu; }
#define XB_SPIN(cond, bar) do { unsigned _sp = 0; while (cond) { __builtin_amdgcn_s_sleep(1); \
    if ((++_sp & 255u) == 0u) { if (xb_ld(&(bar)[XB_TMO])) break; if (_sp > XB_SPIN_CAP) { atomicAdd(&(bar)[XB_TMO], 1u); break; } } } } while (0)
__device__ __forceinline__ void xcd_barrier_complete(unsigned* bar, unsigned x, unsigned& nloc, unsigned& nx) {
  const unsigned G = gridDim.x;
  unsigned sum, cnt, mine, sp = 0u;
  for (;;) {
    sum = 0u; cnt = 0u; mine = 0u;
#pragma unroll
    for (unsigned j = 0; j < 16; ++j) { const unsigned c = xb_ld(&bar[XB_XCNT(j)]); sum += c; cnt += (c > 0u) ? 1u : 0u; mine = (j == x) ? c : mine; }
    if (sum == G) break;
    __builtin_amdgcn_s_sleep(1);
    if ((++sp & 255u) == 0u) { if (xb_ld(&bar[XB_TMO])) break; if (sp > XB_SPIN_CAP) { atomicAdd(&bar[XB_TMO], 1u); break; } }
  }
  nloc = mine > 0u ? mine : 1u; nx = cnt > 0u ? cnt : 1u;
}
__device__ __forceinline__ void grid_barrier(unsigned* bar, unsigned x, volatile unsigned* st) {
  asm volatile("s_waitcnt vmcnt(0)" ::: "memory");
  __syncthreads();
  if (threadIdx.x == 0) {
    __builtin_amdgcn_s_waitcnt(0);
    unsigned nloc = st[0], nx = st[1];
    if (nloc == 0u) { xcd_barrier_complete(bar, x, nloc, nx); st[0] = nloc; st[1] = nx; }
    const unsigned old = xb_add(&bar[XB_XSUB(x)], 1u);
    const unsigned gen = old / nloc;
    if (old + 1u == (gen + 1u) * nloc) {
      __builtin_amdgcn_fence(__ATOMIC_RELEASE, "agent");
      asm volatile("s_waitcnt vmcnt(0)" ::: "memory");
      const unsigned og = xb_add(&bar[XB_TOP], 1u);
      const unsigned tg = og / nx;
      if (og + 1u == (tg + 1u) * nx) xb_add(&bar[XB_TOPGEN], 1u);
      else XB_SPIN(xb_ld(&bar[XB_TOPGEN]) == tg, bar);
      __builtin_amdgcn_fence(__ATOMIC_ACQUIRE, "agent");
      xb_add(&bar[XB_XGEN(x)], 1u);
      asm volatile("s_waitcnt vmcnt(0)" ::: "memory");
    } else {
      XB_SPIN(xb_ld(&bar[XB_XGEN(x)]) == gen, bar);
      __builtin_amdgcn_fence(__ATOMIC_ACQUIRE, "agent");
      asm volatile("s_waitcnt vmcnt(0)" ::: "memory");
    }
  }
  __syncthreads();
}

__device__ void transpose_tile(const float* __restrict__ src, int ld_src, u16* __restrict__ dst, int ld_dst, int k0, int n0, float* tile, bool perm) {
  const int tid = threadIdx.x;
  {
    const int r0 = tid >> 4, c4 = (tid & 15) * 4;
#pragma unroll
    for (int i = 0; i < 4; ++i) {
      const int r = r0 + 16 * i;
      const f32x4 v = *(const f32x4*)(src + (size_t)(k0 + r) * ld_src + n0 + c4);
      tile[r * 65 + c4] = v[0]; tile[r * 65 + c4 + 1] = v[1]; tile[r * 65 + c4 + 2] = v[2]; tile[r * 65 + c4 + 3] = v[3];
    }
  }
  __syncthreads();
  {
    const int k8 = (tid & 7) * 8;
#pragma unroll
    for (int i = 0; i < 2; ++i) {
      const int nn = (tid >> 3) + 32 * i;
      const int col = perm ? (((nn & 15) >> 2) * 16 + (nn >> 4) * 4 + (nn & 3)) : nn;
      unsigned w[4];
#pragma unroll
      for (int e = 0; e < 4; ++e) w[e] = pk_bf16(tile[(k8 + 2 * e) * 65 + col], tile[(k8 + 2 * e + 1) * 65 + col]);
      *(uint4*)(dst + (size_t)(n0 + nn) * ld_dst + k0 + k8) = make_uint4(w[0], w[1], w[2], w[3]);
    }
  }
  __syncthreads();
}

__device__ void norm_rows_bf16(const float* __restrict__ src, const float* __restrict__ gain, u16* __restrict__ dst) {
  const int lane = threadIdx.x & 63;
  const int gw = blockIdx.x * 4 + (threadIdx.x >> 6), nw = gridDim.x * 4;
  f32x4 g[4];
#pragma unroll
  for (int i = 0; i < 4; ++i) g[i] = *(const f32x4*)(gain + i * 256 + lane * 4);
  for (int row = gw; row < NTOK; row += nw) {
    const float* s = src + (size_t)row * DM;
    f32x4 v[4]; float ss = 0.f;
#pragma unroll
    for (int i = 0; i < 4; ++i) { v[i] = *(const f32x4*)(s + i * 256 + lane * 4); ss += v[i][0] * v[i][0] + v[i][1] * v[i][1] + v[i][2] * v[i][2] + v[i][3] * v[i][3]; }
    ss = wave_sum(ss);
    const float rstd = rsqrtf(ss * (1.0f / DM) + 1e-5f);
#pragma unroll
    for (int i = 0; i < 4; ++i) {
      uint2 o; o.x = pk_bf16(v[i][0] * rstd * g[i][0], v[i][1] * rstd * g[i][1]); o.y = pk_bf16(v[i][2] * rstd * g[i][2], v[i][3] * rstd * g[i][3]);
      *(uint2*)(dst + (size_t)row * DM + i * 256 + lane * 4) = o;
    }
  }
}

__device__ void norm_rows_f32_inplace(float* __restrict__ buf, const float* __restrict__ gain) {
  const int lane = threadIdx.x & 63;
  const int gw = blockIdx.x * 4 + (threadIdx.x >> 6), nw = gridDim.x * 4;
  f32x4 g[4];
#pragma unroll
  for (int i = 0; i < 4; ++i) g[i] = *(const f32x4*)(gain + i * 256 + lane * 4);
  for (int row = gw; row < NTOK; row += nw) {
    float* s = buf + (size_t)row * DM;
    f32x4 v[4]; float ss = 0.f;
#pragma unroll
    for (int i = 0; i < 4; ++i) { v[i] = *(const f32x4*)(s + i * 256 + lane * 4); ss += v[i][0] * v[i][0] + v[i][1] * v[i][1] + v[i][2] * v[i][2] + v[i][3] * v[i][3]; }
    ss = wave_sum(ss);
    const float rstd = rsqrtf(ss * (1.0f / DM) + 1e-5f);
#pragma unroll
    for (int i = 0; i < 4; ++i) { f32x4 o = v[i] * rstd * g[i]; *(f32x4*)(s + i * 256 + lane * 4) = o; }
  }
}

__device__ __forceinline__ void weight_jobs(const Params& p, int l, int vb, int nvb, char* smem) {
  float* tile = (float*)smem;
  const int J_WIN = 16 * 54, J_WOUT = 16 * 16, J_UP = 8;
  const int total = J_WIN + J_WOUT + 2 * J_UP;
  for (int job = vb; job < total; job += nvb) {
    if (job < J_WIN) {
      int kt = job / 54, nt = job % 54;
      transpose_tile(p.w_in + (size_t)l * DM * INW, INW, p.WinT + (size_t)l * INW * DM, DM, kt * 64, nt * 64, tile, true);
    } else if (job < J_WIN + J_WOUT) {
      int r = job - J_WIN; int kt = r / 16, nt = r % 16;
      transpose_tile(p.w_out + (size_t)l * DM * DM, DM, p.WoutT + (size_t)l * DM * DM, DM, kt * 64, nt * 64, tile, true);
    } else if (job < J_WIN + J_WOUT + J_UP) {
      int nt = job - J_WIN - J_WOUT;
      transpose_tile(p.w_up + (size_t)l * 64 * 512, 512, p.WupT + (size_t)l * 512 * 64, 64, 0, nt * 64, tile, false);
    } else {
      int nt = job - J_WIN - J_WOUT - J_UP;
      transpose_tile(p.a_up + (size_t)l * 64 * 512, 512, p.AupT + (size_t)l * 512 * 64, 64, 0, nt * 64, tile, false);
    }
  }
}
__device__ __forceinline__ void phase0(const Params& p, char* smem) {
  weight_jobs(p, 0, blockIdx.x, gridDim.x, smem);
  if (gridDim.x <= 64) { }
  norm_rows_bf16(p.x, p.norm_gain, p.h);
}

template <int MODE, bool SWAP>
__device__ __forceinline__ void gemm_tile(const Params& p, const u16* __restrict__ A, const u16* __restrict__ Bt, const float* __restrict__ xold, int m0, int n0, char* smem,
                                          bool staged, bool has_next, int nm0, int nn0) {
  const int tid = threadIdx.x, lane = tid & 63, wid = tid >> 6, wr = wid >> 1, wc = wid & 1, fr = lane & 15, fq = lane >> 4;
  f32x4 acc[4][4];
#pragma unroll
  for (int i = 0; i < 4; ++i)
#pragma unroll
    for (int j = 0; j < 4; ++j) acc[i][j] = (f32x4){0.f, 0.f, 0.f, 0.f};
  const int r8 = lane >> 3, cs = lane & 7;
  const int frsw = (fr >> 1) & 7;
  const u16* gA[4]; const u16* gB[4];
#pragma unroll
  for (int i = 0; i < 4; ++i) {
    const int row = wid * 32 + i * 8 + r8;
    const int c = cs ^ ((row >> 1) & 7);
    gA[i] = A + (size_t)(m0 + row) * DM + c * 8;
    gB[i] = Bt + (size_t)(n0 + row) * DM + c * 8;
  }
  char* lds_w = smem + wid * 4096 + lane * 16;
#define GEMM_STAGE(BUF, KT) { _Pragma("unroll") for (int i = 0; i < 4; ++i) { \
      __builtin_amdgcn_global_load_lds((const unsigned*)(gA[i] + (KT) * 64), (__attribute__((address_space(3))) unsigned*)(lds_w + (BUF) * 32768 + i * 1024), 16, 0, 0); \
      __builtin_amdgcn_global_load_lds((const unsigned*)(gB[i] + (KT) * 64), (__attribute__((address_space(3))) unsigned*)(lds_w + (BUF) * 32768 + 16384 + i * 1024), 16, 0, 0); } }
  if (!staged) GEMM_STAGE(0, 0)
  asm volatile("s_waitcnt vmcnt(0)" ::: "memory");
  __syncthreads();
  const unsigned lds0 = (unsigned)(size_t)(__attribute__((address_space(3))) char*)smem;
  const unsigned a_rd = lds0 + (wr * 64 + fr) * 128, b_rd = lds0 + 16384 + (wc * 64 + fr) * 128;
  const unsigned cof0 = ((0 * 4 + fq) ^ frsw) << 4, cof1 = ((1 * 4 + fq) ^ frsw) << 4;
#define DS_RD(DST, ADDR, OFF) asm volatile("ds_read_b128 %0, %1 offset:" #OFF : "=v"(DST) : "v"(ADDR))
#define WAIT_LGKM_TIED(N, F) asm volatile("s_waitcnt lgkmcnt(" #N ")" : "+v"(F##a[0]), "+v"(F##a[1]), "+v"(F##a[2]), "+v"(F##a[3]), "+v"(F##b[0]), "+v"(F##b[1]), "+v"(F##b[2]), "+v"(F##b[3]))
  for (int kt = 0; kt < 16; ++kt) {
    if (kt < 15) GEMM_STAGE((kt + 1) & 1, kt + 1)
    else if (has_next) {
#pragma unroll
      for (int i = 0; i < 4; ++i) {
        const int row = wid * 32 + i * 8 + r8;
        const int c = cs ^ ((row >> 1) & 7);
        __builtin_amdgcn_global_load_lds((const unsigned*)(A + (size_t)(nm0 + row) * DM + c * 8), (__attribute__((address_space(3))) unsigned*)(lds_w + i * 1024), 16, 0, 0);
        __builtin_amdgcn_global_load_lds((const unsigned*)(Bt + (size_t)(nn0 + row) * DM + c * 8), (__attribute__((address_space(3))) unsigned*)(lds_w + 16384 + i * 1024), 16, 0, 0);
      }
    }
    const unsigned bo = (kt & 1) * 32768;
    bf16x8 f0a[4], f0b[4], f1a[4], f1b[4];
    {
      const unsigned aa0 = a_rd + bo + cof0, ab0 = b_rd + bo + cof0, aa1 = a_rd + bo + cof1, ab1 = b_rd + bo + cof1;
      DS_RD(f0a[0], aa0, 0); DS_RD(f0a[1], aa0, 2048); DS_RD(f0a[2], aa0, 4096); DS_RD(f0a[3], aa0, 6144);
      DS_RD(f0b[0], ab0, 0); DS_RD(f0b[1], ab0, 2048); DS_RD(f0b[2], ab0, 4096); DS_RD(f0b[3], ab0, 6144);
      DS_RD(f1a[0], aa1, 0); DS_RD(f1a[1], aa1, 2048); DS_RD(f1a[2], aa1, 4096); DS_RD(f1a[3], aa1, 6144);
      DS_RD(f1b[0], ab1, 0); DS_RD(f1b[1], ab1, 2048); DS_RD(f1b[2], ab1, 4096); DS_RD(f1b[3], ab1, 6144);
    }
    WAIT_LGKM_TIED(8, f0);
#pragma unroll
    for (int mi = 0; mi < 4; ++mi)
#pragma unroll
      for (int ni = 0; ni < 4; ++ni) {
        if (SWAP) acc[mi][ni] = __builtin_amdgcn_mfma_f32_16x16x32_bf16(f0a[mi], f0b[ni], acc[mi][ni], 0, 0, 0);
        else      acc[mi][ni] = __builtin_amdgcn_mfma_f32_16x16x32_bf16(f0b[ni], f0a[mi], acc[mi][ni], 0, 0, 0);
      }
    WAIT_LGKM_TIED(0, f1);
#pragma unroll
    for (int mi = 0; mi < 4; ++mi)
#pragma unroll
      for (int ni = 0; ni < 4; ++ni) {
        if (SWAP) acc[mi][ni] = __builtin_amdgcn_mfma_f32_16x16x32_bf16(f1a[mi], f1b[ni], acc[mi][ni], 0, 0, 0);
        else      acc[mi][ni] = __builtin_amdgcn_mfma_f32_16x16x32_bf16(f1b[ni], f1a[mi], acc[mi][ni], 0, 0, 0);
      }
    if (kt < 15) {
      asm volatile("s_waitcnt vmcnt(0)" : "+v"(acc[0][0]), "+v"(acc[0][1]), "+v"(acc[0][2]), "+v"(acc[0][3]), "+v"(acc[1][0]), "+v"(acc[1][1]), "+v"(acc[1][2]), "+v"(acc[1][3]),
                   "+v"(acc[2][0]), "+v"(acc[2][1]), "+v"(acc[2][2]), "+v"(acc[2][3]), "+v"(acc[3][0]), "+v"(acc[3][1]), "+v"(acc[3][2]), "+v"(acc[3][3]) :: "memory");
      __syncthreads();
    }
  }
  if (MODE == 1) {
    if (!SWAP) {
      u16* base; int ld, nb;
      if (n0 < SHW) { base = p.projS; ld = SHW; nb = n0; } else { base = p.projR; ld = RW; nb = n0 - SHW; }
#pragma unroll
      for (int mi = 0; mi < 4; ++mi) {
        const int m = m0 + wr * 64 + mi * 16 + fr;
#pragma unroll
        for (int hp = 0; hp < 2; ++hp) {
          const int n = nb + wc * 64 + fq * 16 + hp * 8;
          uint4 o; o.x = pk_bf16(acc[mi][2 * hp][0], acc[mi][2 * hp][1]); o.y = pk_bf16(acc[mi][2 * hp][2], acc[mi][2 * hp][3]);
          o.z = pk_bf16(acc[mi][2 * hp + 1][0], acc[mi][2 * hp + 1][1]); o.w = pk_bf16(acc[mi][2 * hp + 1][2], acc[mi][2 * hp + 1][3]);
          *(uint4*)(base + (size_t)m * ld + n) = o;
        }
      }
    } else {
      const int b = m0 >> 13;
#pragma unroll
      for (int mi = 0; mi < 4; ++mi) {
        const int t = (m0 & (SEQ - 1)) + wr * 64 + mi * 16 + fq * 4;
#pragma unroll
        for (int ni = 0; ni < 4; ++ni) {
          const int nn = wc * 64 + (fr >> 2) * 16 + ni * 4 + (fr & 3);
          uint2 o; o.x = pk_bf16(acc[mi][ni][0], acc[mi][ni][1]); o.y = pk_bf16(acc[mi][ni][2], acc[mi][ni][3]);
          *(uint2*)(p.vT + ((size_t)(b * 128 + nn)) * SEQ + t) = o;
        }
      }
    }
  } else {
#pragma unroll
    for (int mi = 0; mi < 4; ++mi) {
      const int m = m0 + wr * 64 + mi * 16 + fr;
#pragma unroll
      for (int ni = 0; ni < 4; ++ni) {
        const int n = n0 + wc * 64 + fq * 16 + ni * 4;
        f32x4 xo = *(const f32x4*)(xold + (size_t)m * DM + n);
        *(f32x4*)(p.out + (size_t)m * DM + n) = xo + acc[mi][ni];
      }
    }
  }
}

template <int MODE>
__device__ __forceinline__ void gemm_phase(const Params& p, const u16* A, const u16* Bt, const float* xold, int ntn, char* smem) {
  const int total = 256 * ntn;
  bool staged = false;
  for (int t = blockIdx.x; t < total; t += gridDim.x) {
    const int x = t & 7, i = t >> 3;
    const int mg = i / (8 * ntn), rem = i % (8 * ntn), nt = rem >> 3, mi = rem & 7;
    const int mt = x * 32 + mg * 8 + mi;
    const int t2 = t + gridDim.x;
    const bool has_next = t2 < total;
    const int i2 = t2 >> 3, mg2 = i2 / (8 * ntn), rem2 = i2 % (8 * ntn);
    const int nm0 = ((t2 & 7) * 32 + mg2 * 8 + (rem2 & 7)) * 128, nn0 = (rem2 >> 3) * 128;
    if (MODE == 1 && nt == 22) gemm_tile<MODE, true>(p, A, Bt, xold, mt * 128, nt * 128, smem, staged, has_next, nm0, nn0);
    else gemm_tile<MODE, false>(p, A, Bt, xold, mt * 128, nt * 128, smem, staged, has_next, nm0, nn0);
    staged = has_next;
  }
  asm volatile("s_waitcnt vmcnt(0)" ::: "memory");
  __syncthreads();
}

__device__ __forceinline__ void prep_phase(const Params& p, int l, char* smem) {
  const int tid = threadIdx.x, lane = tid & 63, wid = tid >> 6, fr = lane & 15, fq = lane >> 4;
  const float* mu = p.shift_mu + l * SHW;
  const u16* wupT = p.WupT + (size_t)l * 512 * 64;
  const u16* aupT = p.AupT + (size_t)l * 512 * 64;
  const float* w0 = p.w0 + l * 512; const float* a0 = p.a0 + l * 512;
  const float* kkw = p.k_k + l * 512; const float* kaw = p.k_a + l * 512; const float* rkw = p.r_k + l * 512;
  u16* s_nkk = p.sc; u16* s_e = p.sc + SCN; u16* s_b = p.sc + 2 * SCN; u16* s_kp = p.sc + 3 * SCN; u16* s_r = p.sc + 4 * SCN; u16* s_v = p.sc + 5 * SCN;
  float* lp = (float*)(smem + 16384);
  {
#pragma unroll
    for (int i = 0; i < 4; ++i) {
      const int e = (tid + 256 * i) * 4;
      const int arr = e >> 9, c = e & 511;
      const float* srcp = arr < 3 ? (mu + arr * 512 + c) : arr == 3 ? (w0 + c) : arr == 4 ? (a0 + c) : arr == 5 ? (kkw + c) : arr == 6 ? (kaw + c) : (rkw + c);
      *(f32x4*)(lp + e) = *(const f32x4*)srcp;
    }
  }
  __syncthreads();
  for (int tile = blockIdx.x; tile < 512; tile += gridDim.x) {
    const int tok0 = tile * 64;
    {
      const int tk = tid >> 2, part = tid & 3;
      const int tok = tok0 + tk;
      const bool first = (tok & (SEQ - 1)) == 0;
      const u16* cur = p.projS + (size_t)tok * SHW;
#pragma unroll
      for (int which = 0; which < 2; ++which) {
        const int col = (which ? C_AD : C_WD) + part * 16;
        uint4 c0 = *(const uint4*)(cur + col), c1 = *(const uint4*)(cur + col + 8);
        uint4 p0 = make_uint4(0, 0, 0, 0), p1 = make_uint4(0, 0, 0, 0);
        if (!first) { p0 = *(const uint4*)(cur - SHW + col); p1 = *(const uint4*)(cur - SHW + col + 8); }
        unsigned cu[8] = {c0.x, c0.y, c0.z, c0.w, c1.x, c1.y, c1.z, c1.w};
        unsigned pu[8] = {p0.x, p0.y, p0.z, p0.w, p1.x, p1.y, p1.z, p1.w};
        unsigned ou[8];
#pragma unroll
        for (int i = 0; i < 8; ++i) {
          float ca = bf_lo(cu[i]), cb = bf_hi(cu[i]), pa = bf_lo(pu[i]), pb = bf_hi(pu[i]);
          float xa = ca + (pa - ca) * mu[col + 2 * i], xb = cb + (pb - cb) * mu[col + 2 * i + 1];
          if (which == 0) { xa = tanhf_(xa); xb = tanhf_(xb); }
          ou[i] = pk_bf16(xa, xb);
        }
        const int sw = (tk >> 1) & 7;
        char* dst = smem + which * 8192 + tk * 128;
        *(uint4*)(dst + (((part * 2) ^ sw) << 4)) = make_uint4(ou[0], ou[1], ou[2], ou[3]);
        *(uint4*)(dst + (((part * 2 + 1) ^ sw) << 4)) = make_uint4(ou[4], ou[5], ou[6], ou[7]);
      }
    }
    __syncthreads();
#pragma unroll 1
    for (int hq = 0; hq < 8; ++hq) {
      const int hh = hq >> 2, mq = hq & 3;
      const int head = wid * 2 + hh;
      f32x4 aw[4][1], aa[4][1];
#pragma unroll
      for (int i = 0; i < 4; ++i) { aw[i][0] = (f32x4){0.f, 0.f, 0.f, 0.f}; aa[i][0] = (f32x4){0.f, 0.f, 0.f, 0.f}; }
#pragma unroll
      for (int ks = 0; ks < 2; ++ks) {
        const int coff = ((ks * 4 + fq) ^ ((fr >> 1) & 7)) << 4;
        const bf16x8 xw = *(const bf16x8*)(smem + (mq * 16 + fr) * 128 + coff);
        const bf16x8 xa = *(const bf16x8*)(smem + 8192 + (mq * 16 + fr) * 128 + coff);
#pragma unroll
        for (int ni = 0; ni < 4; ++ni) {
          const int n = head * 64 + (fr >> 2) * 16 + ni * 4 + (fr & 3);
          const bf16x8 wf = *(const bf16x8*)(wupT + n * 64 + ks * 32 + fq * 8);
          const bf16x8 af = *(const bf16x8*)(aupT + n * 64 + ks * 32 + fq * 8);
          aw[ni][0] = __builtin_amdgcn_mfma_f32_16x16x32_bf16(wf, xw, aw[ni][0], 0, 0, 0);
          aa[ni][0] = __builtin_amdgcn_mfma_f32_16x16x32_bf16(af, xa, aa[ni][0], 0, 0, 0);
        }
      }
#pragma unroll
      for (int mi = 0; mi < 1; ++mi) {
        const int tok = tok0 + mq * 16 + fr;
        const bool first = (tok & (SEQ - 1)) == 0;
        const int b = tok >> 13, t = tok & (SEQ - 1);
        const u16* cur = p.projS + (size_t)tok * SHW;
        const size_t obase = ((size_t)(b * 8 + head) * SEQ + t) * 64;
        float kkv[4][4], al[4][4];
        float ssq = 0.f, rks = 0.f;
#pragma unroll
        for (int hp = 0; hp < 2; ++hp) {
          const int cb8 = head * 64 + fq * 16 + hp * 8;
          const uint4 cr4 = *(const uint4*)(cur + C_R + cb8), ck4 = *(const uint4*)(cur + C_K + cb8), cv4 = *(const uint4*)(cur + C_V + cb8);
          uint4 pr4 = make_uint4(0, 0, 0, 0), pk4 = make_uint4(0, 0, 0, 0), pv4 = make_uint4(0, 0, 0, 0);
          if (!first) { pr4 = *(const uint4*)(cur - SHW + C_R + cb8); pk4 = *(const uint4*)(cur - SHW + C_K + cb8); pv4 = *(const uint4*)(cur - SHW + C_V + cb8); }
          unsigned ro_[4], ko_[4], vo_[4], eo_[4];
#pragma unroll
          for (int q = 0; q < 2; ++q) {
            const int ni = hp * 2 + q, cb = cb8 + q * 4;
            const uint2 cr = q ? make_uint2(cr4.z, cr4.w) : make_uint2(cr4.x, cr4.y), ck = q ? make_uint2(ck4.z, ck4.w) : make_uint2(ck4.x, ck4.y), cv = q ? make_uint2(cv4.z, cv4.w) : make_uint2(cv4.x, cv4.y);
            const uint2 pr = q ? make_uint2(pr4.z, pr4.w) : make_uint2(pr4.x, pr4.y), pk = q ? make_uint2(pk4.z, pk4.w) : make_uint2(pk4.x, pk4.y), pv = q ? make_uint2(pv4.z, pv4.w) : make_uint2(pv4.x, pv4.y);
            const f32x4 mr = *(const f32x4*)(lp + 0 * 512 + cb), mk = *(const f32x4*)(lp + 1 * 512 + cb), mv = *(const f32x4*)(lp + 2 * 512 + cb);
            const f32x4 w0v = *(const f32x4*)(lp + 3 * 512 + cb), a0v = *(const f32x4*)(lp + 4 * 512 + cb), kkc = *(const f32x4*)(lp + 5 * 512 + cb), kac = *(const f32x4*)(lp + 6 * 512 + cb), rkc = *(const f32x4*)(lp + 7 * 512 + cb);
            float rc[4] = {bf_lo(cr.x), bf_hi(cr.x), bf_lo(cr.y), bf_hi(cr.y)}, rp[4] = {bf_lo(pr.x), bf_hi(pr.x), bf_lo(pr.y), bf_hi(pr.y)};
            float kc[4] = {bf_lo(ck.x), bf_hi(ck.x), bf_lo(ck.y), bf_hi(ck.y)}, kp_[4] = {bf_lo(pk.x), bf_hi(pk.x), bf_lo(pk.y), bf_hi(pk.y)};
            float vc[4] = {bf_lo(cv.x), bf_hi(cv.x), bf_lo(cv.y), bf_hi(cv.y)}, vp[4] = {bf_lo(pv.x), bf_hi(pv.x), bf_lo(pv.y), bf_hi(pv.y)};
            float ro[4], ko[4], vo[4], eo[4];
#pragma unroll
            for (int j = 0; j < 4; ++j) {
              const float r = rc[j] + (rp[j] - rc[j]) * mr[j];
              const float k = kc[j] + (kp_[j] - kc[j]) * mk[j];
              const float v = vc[j] + (vp[j] - vc[j]) * mv[j];
              const float a = sigmoidf_(a0v[j] + aa[ni][mi][j]);
              const float e = 0.60653066f * sigmoidf_(w0v[j] + aw[ni][mi][j]);
              const float kk = k * kkc[j];
              const float kpr = k * (1.0f + (a - 1.0f) * kac[j]);
              ssq += kk * kk; rks += r * kpr * rkc[j];
              kkv[ni][j] = kk; al[ni][j] = a;
              ro[j] = r; ko[j] = kpr; vo[j] = v; eo[j] = e;
            }
            ro_[2 * q] = pk_bf16(ro[0], ro[1]); ro_[2 * q + 1] = pk_bf16(ro[2], ro[3]);
            ko_[2 * q] = pk_bf16(ko[0], ko[1]); ko_[2 * q + 1] = pk_bf16(ko[2], ko[3]);
            vo_[2 * q] = pk_bf16(vo[0], vo[1]); vo_[2 * q + 1] = pk_bf16(vo[2], vo[3]);
            eo_[2 * q] = pk_bf16(eo[0], eo[1]); eo_[2 * q + 1] = pk_bf16(eo[2], eo[3]);
          }
          const size_t o = obase + fq * 16 + hp * 8;
          *(uint4*)(s_r + o) = make_uint4(ro_[0], ro_[1], ro_[2], ro_[3]);
          *(uint4*)(s_kp + o) = make_uint4(ko_[0], ko_[1], ko_[2], ko_[3]);
          *(uint4*)(s_v + o) = make_uint4(vo_[0], vo_[1], vo_[2], vo_[3]);
          *(uint4*)(s_e + o) = make_uint4(eo_[0], eo_[1], eo_[2], eo_[3]);
        }
        ssq += __shfl_xor(ssq, 16); ssq += __shfl_xor(ssq, 32);
        rks += __shfl_xor(rks, 16); rks += __shfl_xor(rks, 32);
        const float inv = 1.0f / fmaxf(sqrtf(ssq), 1e-12f);
#pragma unroll
        for (int hp = 0; hp < 2; ++hp) {
          const size_t o = obase + fq * 16 + hp * 8;
          unsigned nn_[4], bb_[4];
#pragma unroll
          for (int q = 0; q < 2; ++q) {
            const int ni = hp * 2 + q;
            const float n0_ = kkv[ni][0] * inv, n1 = kkv[ni][1] * inv, n2 = kkv[ni][2] * inv, n3 = kkv[ni][3] * inv;
            nn_[2 * q] = pk_bf16(-n0_, -n1); nn_[2 * q + 1] = pk_bf16(-n2, -n3);
            bb_[2 * q] = pk_bf16(n0_ * al[ni][0], n1 * al[ni][1]); bb_[2 * q + 1] = pk_bf16(n2 * al[ni][2], n3 * al[ni][3]);
          }
          *(uint4*)(s_nkk + o) = make_uint4(nn_[0], nn_[1], nn_[2], nn_[3]);
          *(uint4*)(s_b + o) = make_uint4(bb_[0], bb_[1], bb_[2], bb_[3]);
        }
        if (fq == 0) p.rk[(size_t)(b * 8 + head) * SEQ + t] = rks;
      }
    }
    __syncthreads();
  }
}

typedef float f32x2 __attribute__((ext_vector_type(2)));
#define SCH 16
#define NPR 8
#define OPB_F (9 * NPR * 64)
__device__ __forceinline__ f32x2 lo2(f32x4 v) { return (f32x2){v[0], v[1]}; }
__device__ __forceinline__ f32x2 hi2(f32x4 v) { return (f32x2){v[2], v[3]}; }
__device__ void scan_block(const Params& p, int sb, char* smem) {
  const int tid = threadIdx.x, lane = tid & 63, wid = tid >> 6;
  const int bh = sb >> 3, r8 = sb & 7;
  const int b = bh >> 3, head = bh & 7;
  float* opb = (float*)smem;
  float* scb = opb + 2 * OPB_F;
  float* vb = scb + 2 * NPR * 4;
  float* yb = vb + 2 * 8 * SCH;
  const size_t base = (size_t)bh * SEQ * 64;
  constexpr int NCH = SEQ / SCH;
  if (wid < 2) {
    __builtin_amdgcn_s_setprio(3);
    const int rg = lane >> 4, c = lane & 15, rowl = wid * 4 + rg;
    f32x2 S01 = {0.f, 0.f}, S23 = {0.f, 0.f};
    __syncthreads();
    for (int ch = 0; ch < NCH; ++ch) {
      const f32x4* o4 = (const f32x4*)(opb + (ch & 1) * OPB_F) + c;
      const f32x4* s4 = (const f32x4*)(scb + (ch & 1) * NPR * 4);
      const f32x4* v4 = (const f32x4*)(vb + (ch & 1) * 8 * SCH + rowl * SCH);
      float* ypart = yb + (ch & 1) * (SCH * 128) + rowl * 16 + c;
      f32x4 A1 = o4[0 * 128], A2 = o4[1 * 128], R1 = o4[2 * 128], D12 = o4[3 * 128], B1 = o4[4 * 128], K1 = o4[5 * 128], b2 = o4[6 * 128], k2 = o4[7 * 128], r2 = o4[8 * 128], cs = s4[0];
      f32x4 vq[4];
#pragma unroll
      for (int i = 0; i < 4; ++i) vq[i] = v4[i];
#pragma unroll
      for (int j = 0; j < NPR; ++j) {
        const f32x4 A1n = o4[0 * 128 + (j + 1) * 16], A2n = o4[1 * 128 + (j + 1) * 16], R1n = o4[2 * 128 + (j + 1) * 16], D12n = o4[3 * 128 + (j + 1) * 16], B1n = o4[4 * 128 + (j + 1) * 16],
                    K1n = o4[5 * 128 + (j + 1) * 16], b2n = o4[6 * 128 + (j + 1) * 16], k2n = o4[7 * 128 + (j + 1) * 16], r2n = o4[8 * 128 + (j + 1) * 16], csn = s4[j + 1];
        asm volatile("" ::: "memory");
        const float v1 = vq[j >> 1][(2 * j) & 3], v2 = vq[j >> 1][(2 * j + 1) & 3];
        f32x2 t1 = S01 * lo2(A1); t1 = __builtin_elementwise_fma(S23, hi2(A1), t1);
        f32x2 t2 = S01 * lo2(A2); t2 = __builtin_elementwise_fma(S23, hi2(A2), t2);
        f32x2 t3 = S01 * lo2(R1); t3 = __builtin_elementwise_fma(S23, hi2(R1), t3);
        float p1 = t1[0] + t1[1], p2 = t2[0] + t2[1], q1 = t3[0] + t3[1];
        p1 = row16_sum(p1); p2 = row16_sum(p2);
        const float u1 = p1;
        const float u2 = fmaf(u1, cs[0], fmaf(v1, cs[1], p2));
        ypart[(2 * j) * 128] = fmaf(u1, cs[2], fmaf(v1, cs[3], q1));
        const f32x2 u1v = {u1, u1}, v1v = {v1, v1}, u2v = {u2, u2}, v2v = {v2, v2};
        S01 = S01 * lo2(D12); S23 = S23 * hi2(D12);
        S01 = __builtin_elementwise_fma(u1v, lo2(B1), S01); S23 = __builtin_elementwise_fma(u1v, hi2(B1), S23);
        S01 = __builtin_elementwise_fma(v1v, lo2(K1), S01); S23 = __builtin_elementwise_fma(v1v, hi2(K1), S23);
        S01 = __builtin_elementwise_fma(u2v, lo2(b2), S01); S23 = __builtin_elementwise_fma(u2v, hi2(b2), S23);
        S01 = __builtin_elementwise_fma(v2v, lo2(k2), S01); S23 = __builtin_elementwise_fma(v2v, hi2(k2), S23);
        f32x2 t4 = S01 * lo2(r2); t4 = __builtin_elementwise_fma(S23, hi2(r2), t4);
        ypart[(2 * j + 1) * 128] = t4[0] + t4[1];
        A1 = A1n; A2 = A2n; R1 = R1n; D12 = D12n; B1 = B1n; K1 = K1n; b2 = b2n; k2 = k2n; r2 = r2n; cs = csn;
      }
      __syncthreads();
    }
    __builtin_amdgcn_s_setprio(0);
  } else {
    const int ht = tid - 128;
    const int pr = ht >> 4, cg = ht & 15;
    const int st = ht >> 3, vrow = ht & 7;
    const u16* gsrc = p.sc + base + (size_t)(2 * pr) * 64 + 4 * cg;
    const u16* vsrc = p.sc + 5 * SCN + base + (size_t)st * 64 + r8 * 8 + vrow;
    uint2 rg0[10], rg1[10]; u16 rv0, rv1;
#define H_LOAD(R, RV, CH) { _Pragma("unroll") for (int a = 0; a < 5; ++a) { R[2 * a] = *(const uint2*)(gsrc + a * SCN + (size_t)(CH) * (SCH * 64)); R[2 * a + 1] = *(const uint2*)(gsrc + a * SCN + (size_t)(CH) * (SCH * 64) + 64); } RV = vsrc[(size_t)(CH) * (SCH * 64)]; }
#define H_UNPK(U) (f32x4){bf_lo((U).x), bf_hi((U).x), bf_lo((U).y), bf_hi((U).y)}
#define H_CONV(R, RV, BUF) { \
      const f32x4 n1 = H_UNPK(R[0]), n2 = H_UNPK(R[1]), e1 = H_UNPK(R[2]), e2 = H_UNPK(R[3]), b1 = H_UNPK(R[4]), b2_ = H_UNPK(R[5]), k1 = H_UNPK(R[6]), k2_ = H_UNPK(R[7]), r1 = H_UNPK(R[8]), r2_ = H_UNPK(R[9]); \
      const f32x4 d1 = (f32x4){__expf(-e1[0]), __expf(-e1[1]), __expf(-e1[2]), __expf(-e1[3])}, d2 = (f32x4){__expf(-e2[0]), __expf(-e2[1]), __expf(-e2[2]), __expf(-e2[3])}; \
      float* ob = opb + (BUF) * OPB_F + pr * 64 + 4 * cg; \
      *(f32x4*)(ob + 0 * 512) = n1; *(f32x4*)(ob + 1 * 512) = d1 * n2; *(f32x4*)(ob + 2 * 512) = d1 * r1; *(f32x4*)(ob + 3 * 512) = d1 * d2; \
      *(f32x4*)(ob + 4 * 512) = b1 * d2; *(f32x4*)(ob + 5 * 512) = k1 * d2; *(f32x4*)(ob + 6 * 512) = b2_; *(f32x4*)(ob + 7 * 512) = k2_; *(f32x4*)(ob + 8 * 512) = r2_; \
      const f32x4 m0 = b1 * n2, m1 = k1 * n2, m2 = b1 * r1, m3 = k1 * r1; \
      float c0 = (m0[0] + m0[1]) + (m0[2] + m0[3]), c1 = (m1[0] + m1[1]) + (m1[2] + m1[3]), c2 = (m2[0] + m2[1]) + (m2[2] + m2[3]), c3 = (m3[0] + m3[1]) + (m3[2] + m3[3]); \
      c0 = row16_sum(c0); c1 = row16_sum(c1); c2 = row16_sum(c2); c3 = row16_sum(c3); \
      if (cg == 0) *(f32x4*)(scb + (BUF) * NPR * 4 + pr * 4) = (f32x4){c0, c1, c2 * 0.0625f, c3 * 0.0625f}; \
      vb[(BUF) * 8 * SCH + vrow * SCH + st] = __uint_as_float(((unsigned)RV) << 16); }
#define H_YRED(CH) { const f32x4* y4 = (const f32x4*)(yb + ((CH) & 1) * (SCH * 128) + st * 128 + vrow * 16); \
      const f32x4 a_ = y4[0] + y4[1], b_ = y4[2] + y4[3]; const f32x4 c_ = a_ + b_; \
      p.yraw[((size_t)b * SEQ + (size_t)(CH) * SCH + st) * 512 + head * 64 + r8 * 8 + vrow] = (c_[0] + c_[1]) + (c_[2] + c_[3]); }
    H_LOAD(rg0, rv0, 0)
    H_LOAD(rg1, rv1, 1)
    H_CONV(rg0, rv0, 0)
    H_LOAD(rg0, rv0, 2)
    __syncthreads();
    for (int ch = 0; ch < NCH; ch += 2) {
      H_CONV(rg1, rv1, 1)
      if (ch + 3 < NCH) H_LOAD(rg1, rv1, ch + 3)
      if (ch >= 1) H_YRED(ch - 1)
      __syncthreads();
      if (ch + 2 < NCH) H_CONV(rg0, rv0, 0)
      if (ch + 4 < NCH) H_LOAD(rg0, rv0, ch + 4)
      H_YRED(ch)
      __syncthreads();
    }
    H_YRED(NCH - 1)
  }
}


#define CP_LD 68
__device__ __forceinline__ void chunkprep_phase(const Params& p, char* smem, int c_lo, int lg, int vb, int nvb) {
  float* fA = (float*)smem;
  float* fR = fA + 16 * CP_LD;
  float* fB = fR + 16 * CP_LD;
  float* fK = fB + 16 * CP_LD;
  float* fV = fK + 16 * CP_LD;
  float* fG = fV + 16 * CP_LD;
  float* fW = fG + 16 * CP_LD;
  float* fM = fW + 16 * CP_LD;
  float* gL = fM + 4 * 256;
  float* mbuf = gL + 64;
  const int tid = threadIdx.x, lane = tid & 63, wid = tid >> 6;
  const int nitems = 32 << lg, cmask = (1 << lg) - 1;
  int nb = 0, first_item = 0;
  u32x2 u[6];
  if (vb < nitems) {
    const int bh0 = vb >> lg, c0 = c_lo + (vb & cmask);
    const u16* src0 = p.sc + ((size_t)bh0 * SEQ + (size_t)c0 * 16) * 64 + (tid >> 4) * 64 + (tid & 15) * 4;
#pragma unroll
    for (int a = 0; a < 6; ++a) u[a] = gload8_async(src0 + a * SCN);
  }
  for (int idx = vb; idx < nitems; idx += nvb) {
    if (nb == 0) first_item = idx;
    const int bh = idx >> lg, c = c_lo + (idx & cmask);
    const int item = bh * 512 + c;
    const size_t goff = ((size_t)bh * SEQ + (size_t)c * 16) * 64;
    {
      const int t = tid >> 4, j4 = (tid & 15) * 4;
      if (idx == vb) asm volatile("s_waitcnt vmcnt(0)" ::: "memory"); else asm volatile("s_waitcnt vmcnt(3)" ::: "memory");
      const int o = t * CP_LD + j4;
      *(f32x4*)(fA + o) = (f32x4){bf_lo(u[0].x), bf_hi(u[0].x), bf_lo(u[0].y), bf_hi(u[0].y)};
      *(f32x4*)(fG + o) = (f32x4){__expf(-bf_lo(u[1].x)), __expf(-bf_hi(u[1].x)), __expf(-bf_lo(u[1].y)), __expf(-bf_hi(u[1].y))};
      *(f32x4*)(fB + o) = (f32x4){bf_lo(u[2].x), bf_hi(u[2].x), bf_lo(u[2].y), bf_hi(u[2].y)};
      *(f32x4*)(fK + o) = (f32x4){bf_lo(u[3].x), bf_hi(u[3].x), bf_lo(u[3].y), bf_hi(u[3].y)};
      *(f32x4*)(fR + o) = (f32x4){bf_lo(u[4].x), bf_hi(u[4].x), bf_lo(u[4].y), bf_hi(u[4].y)};
      *(f32x4*)(fV + o) = (f32x4){bf_lo(u[5].x), bf_hi(u[5].x), bf_lo(u[5].y), bf_hi(u[5].y)};
      const int nidx = idx + nvb;
      if (nidx < nitems) {
        const u16* srcn = p.sc + ((size_t)(nidx >> lg) * SEQ + (size_t)(c_lo + (nidx & cmask)) * 16) * 64 + t * 64 + j4;
        asm volatile("" ::: "memory");
#pragma unroll
        for (int a = 0; a < 6; ++a) u[a] = gload8_async(srcn + a * SCN);
      }
    }
    __syncthreads();
    {
      const int j = tid & 63, part = tid >> 6;
      float g[16];
#pragma unroll
      for (int t = 0; t < 16; ++t) g[t] = fG[t * CP_LD + j];
#pragma unroll
      for (int t = 1; t < 16; ++t) g[t] *= g[t - 1];
      float* arr = part == 0 ? fA : part == 1 ? fR : part == 2 ? fB : fK;
#pragma unroll
      for (int t = 0; t < 16; ++t) {
        const float f = part == 0 ? (t == 0 ? 1.0f : g[t > 0 ? t - 1 : 0]) : part == 1 ? g[t] : __builtin_amdgcn_rcpf(g[t]);
        arr[t * CP_LD + j] *= f;
      }
      if (part == 0) gL[j] = g[15];
    }
    __syncthreads();
    {
      const float* xa = (wid < 2 ? fA : fR) + (lane & 15) * CP_LD + (lane >> 4);
      const float* xb = ((wid & 1) ? fK : fB) + (lane & 15) * CP_LD + (lane >> 4);
      f32x4 acc4[4];
#pragma unroll
      for (int c4 = 0; c4 < 4; ++c4) acc4[c4] = (f32x4){0.f, 0.f, 0.f, 0.f};
#pragma unroll
      for (int ks = 0; ks < 16; ++ks) acc4[ks & 3] = __builtin_amdgcn_mfma_f32_16x16x4f32(xa[ks * 4], xb[ks * 4], acc4[ks & 3], 0, 0, 0);
      const f32x4 acc = (acc4[0] + acc4[1]) + (acc4[2] + acc4[3]);
      const int s2 = lane & 15;
#pragma unroll
      for (int r = 0; r < 4; ++r) {
        const int t = (lane >> 4) * 4 + r;
        const bool keep = wid < 2 ? (s2 < t) : (s2 <= t);
        const float mval = keep ? acc[r] : 0.f;
        fM[wid * 256 + t * 16 + s2] = mval;
        if (wid == 0) mbuf[nb * 256 + t * 16 + s2] = mval;
      }
    }
    __syncthreads();
    {
      const int t = tid >> 4, i4 = (tid & 15) * 4;
      f32x4 acc = (f32x4){0.f, 0.f, 0.f, 0.f};
#pragma unroll
      for (int q = 0; q < 4; ++q) {
        const f32x4 m = *(const f32x4*)(fM + 256 + t * 16 + q * 4);
#pragma unroll
        for (int e = 0; e < 4; ++e) acc += m[e] * *(const f32x4*)(fV + (q * 4 + e) * CP_LD + i4);
      }
      *(f32x4*)(fW + t * CP_LD + i4) = acc;
    }
    __syncthreads();
    {
      const int pz = tid;
      const int hs = pz >> 7, ph = pz & 127;
      {
        const int kk = ph >> 6, ln = ph & 63, t = ln & 15, quad = ln >> 4, j = 32 * kk + quad * 4;
        const float* src = (hs ? fR : fA) + t * CP_LD + j;
        const f32x4 x = *(const f32x4*)src, y = *(const f32x4*)(src + 16);
        *(uint4*)(p.sc + hs * SCN + goff + ph * 8) = make_uint4(pk_bf16(x[0], x[1]), pk_bf16(x[2], x[3]), pk_bf16(y[0], y[1]), pk_bf16(y[2], y[3]));
      }
      {
        const int jt = ph >> 5, ln = (ph & 31) * 2, j = jt * 16 + (ln & 15), quad = ln >> 4;
        const float* src = hs ? fK : fB;
        const float g0 = gL[j], g1 = gL[j + 1];
        float q0[4], q1[4];
#pragma unroll
        for (int r = 0; r < 4; ++r) { q0[r] = src[(quad * 4 + r) * CP_LD + j] * g0; q1[r] = src[(quad * 4 + r) * CP_LD + j + 1] * g1; }
        *(uint4*)(p.sc + (2 + hs) * SCN + goff + ph * 8) = make_uint4(pk_bf16(q0[0], q0[1]), pk_bf16(q0[2], q0[3]), pk_bf16(q1[0], q1[1]), pk_bf16(q1[2], q1[3]));
      }
      {
        const int it = ph >> 5, ln = (ph & 31) * 2, i = it * 16 + (ln & 15), quad = ln >> 4;
        const float* src = hs ? fV : fW;
        float q0[4], q1[4];
#pragma unroll
        for (int r = 0; r < 4; ++r) { q0[r] = src[(quad * 4 + r) * CP_LD + i]; q1[r] = src[(quad * 4 + r) * CP_LD + i + 1]; }
        *(uint4*)(p.sc + (4 + hs) * SCN + goff + ph * 8) = make_uint4(pk_bf16(q0[0], q0[1]), pk_bf16(q0[2], q0[3]), pk_bf16(q1[0], q1[1]), pk_bf16(q1[2], q1[3]));
      }
      if (pz < 64) {
        const int t = pz & 15, quad = pz >> 4;
        const f32x4 x = *(const f32x4*)(fM + 2 * 256 + t * 16 + quad * 4), y = *(const f32x4*)(fM + 3 * 256 + t * 16 + quad * 4);
        *(uint4*)(p.exy0 + (size_t)item * 1024 + 512 + pz * 8) = make_uint4(pk_bf16(x[0], x[1]), pk_bf16(x[2], x[3]), pk_bf16(y[0], y[1]), pk_bf16(y[2], y[3]));
      }
      if (tid < 64) p.exg[(size_t)item * 64 + tid] = gL[tid];
    }
    ++nb;
    const bool last = idx + nvb >= nitems;
    if (nb == 16 || last) {
      __syncthreads();
      const int k = wid * 4 + (lane >> 4), cidx = lane & 15;
      if (k < nb) {
        const float* mb = mbuf + k * 256;
        float T_[16];
#pragma unroll
        for (int t = 0; t < 16; ++t) {
          float acc = (t == cidx) ? 1.0f : 0.0f;
#pragma unroll
          for (int q = 0; q < 4; ++q) {
            if (q * 4 < t) {
              const f32x4 m = *(const f32x4*)(mb + t * 16 + q * 4);
#pragma unroll
              for (int e = 0; e < 4; ++e) { const int s2 = q * 4 + e; if (s2 < t) acc = fmaf(m[e], T_[s2], acc); }
            }
          }
          T_[t] = acc;
        }
        float* tb = mbuf + k * 256;
#pragma unroll
        for (int t = 0; t < 16; ++t) tb[t * 16 + cidx] = T_[t];
        asm volatile("s_waitcnt lgkmcnt(0)" ::: "memory");
        const int kidx = first_item + k * nvb;
        u16* dst = p.exy0 + (size_t)((kidx >> lg) * 512 + c_lo + (kidx & cmask)) * 1024;
#pragma unroll
        for (int q = 0; q < 4; ++q) {
          const int lp = q * 16 + cidx, tq = lp & 15, qd = lp >> 4;
          const f32x4 x = *(const f32x4*)(tb + tq * 16 + qd * 4);
          *(uint4*)(dst + lp * 8) = make_uint4(pk_bf16(x[0], x[1]), pk_bf16(x[2], x[3]), 0u, 0u);
        }
      }
      nb = 0;
    }
    __syncthreads();
  }
}

#define CS_SLOT 11520
#define CS_RING 5
#define CS_NCH 512
__device__ __forceinline__ void chunkscan_block(const Params& p, int cb, char* smem, int c_lo, int nchl, f32x4 (&z)[4]) {
  const int tid = threadIdx.x, lane = tid & 63, wid = tid >> 6;
  const int bh = (cb & 7) * 4 + (cb >> 5), it = (cb >> 3) & 3, b = bh >> 3, head = bh & 7;
  if (wid == 0) {
    __builtin_amdgcn_s_setprio(3);
    const int fr = lane & 15, quad = lane >> 4;
    if (c_lo == 0) {
#pragma unroll
      for (int jt = 0; jt < 4; ++jt) z[jt] = (f32x4){0.f, 0.f, 0.f, 0.f};
    }
    u16* yo = (u16*)p.yraw + ((size_t)b * SEQ + (size_t)c_lo * 16 + quad * 4) * 512 + head * 64 + it * 16 + fr;
    asm volatile("s_waitcnt lgkmcnt(0)\n\ts_barrier" ::: "memory");
#define CS_LOADOPS(SL) { const char* sl_ = (SL); \
      af0 = *(const bf16x8*)(sl_ + lane * 16); af1 = *(const bf16x8*)(sl_ + 1024 + lane * 16); \
      rf0 = *(const bf16x8*)(sl_ + 2048 + lane * 16); rf1 = *(const bf16x8*)(sl_ + 3072 + lane * 16); \
      tf = *(const bf16x8*)(sl_ + 9216 + lane * 16); mf = *(const bf16x8*)(sl_ + 10240 + lane * 16); \
      xx = *(const uint2*)(sl_ + 8192 + lane * 8); vv = *(const uint2*)(sl_ + 8704 + lane * 8); \
      _Pragma("unroll") for (int jt = 0; jt < 4; ++jt) { gam[jt] = *(const f32x4*)(sl_ + 11264 + (jt * 16 + quad * 4) * 4); \
        bkl[jt] = *(const uint2*)(sl_ + 4096 + (jt * 64 + lane) * 8); bkh[jt] = *(const uint2*)(sl_ + 6144 + (jt * 64 + lane) * 8); } }
    bf16x8 af0, af1, rf0, rf1, tf, mf; uint2 xx, vv; f32x4 gam[4]; uint2 bkl[4], bkh[4];
    CS_LOADOPS(smem)
    int slot = 1;
    for (int c = 0; c < nchl; ++c) {
      union { unsigned u[4]; bf16x8 v; } zb0, zb1;
      zb0.u[0] = pk_bf16(z[0][0], z[0][1]); zb0.u[1] = pk_bf16(z[0][2], z[0][3]); zb0.u[2] = pk_bf16(z[1][0], z[1][1]); zb0.u[3] = pk_bf16(z[1][2], z[1][3]);
      zb1.u[0] = pk_bf16(z[2][0], z[2][1]); zb1.u[1] = pk_bf16(z[2][2], z[2][3]); zb1.u[2] = pk_bf16(z[3][0], z[3][1]); zb1.u[3] = pk_bf16(z[3][2], z[3][3]);
      f32x4 u0 = (f32x4){bf_lo(xx.x), bf_hi(xx.x), bf_lo(xx.y), bf_hi(xx.y)}, y = (f32x4){0.f, 0.f, 0.f, 0.f};
      u0 = __builtin_amdgcn_mfma_f32_16x16x32_bf16(af0, zb0.v, u0, 0, 0, 0);
      y = __builtin_amdgcn_mfma_f32_16x16x32_bf16(rf0, zb0.v, y, 0, 0, 0);
      u0 = __builtin_amdgcn_mfma_f32_16x16x32_bf16(af1, zb1.v, u0, 0, 0, 0);
      y = __builtin_amdgcn_mfma_f32_16x16x32_bf16(rf1, zb1.v, y, 0, 0, 0);
      union { unsigned u[4]; bf16x8 v; } ub, uv;
      ub.u[0] = pk_bf16(u0[0], u0[1]); ub.u[1] = pk_bf16(u0[2], u0[3]); ub.u[2] = 0u; ub.u[3] = 0u;
      const f32x4 u = __builtin_amdgcn_mfma_f32_16x16x32_bf16(tf, ub.v, (f32x4){0.f, 0.f, 0.f, 0.f}, 0, 0, 0);
      uv.u[0] = pk_bf16(u[0], u[1]); uv.u[1] = pk_bf16(u[2], u[3]); uv.u[2] = vv.x; uv.u[3] = vv.y;
      y = __builtin_amdgcn_mfma_f32_16x16x32_bf16(mf, uv.v, y, 0, 0, 0);
#pragma unroll
      for (int jt = 0; jt < 4; ++jt) {
        union { uint2 h[2]; bf16x8 v; } bk;
        bk.h[0] = bkl[jt]; bk.h[1] = bkh[jt];
        z[jt] = __builtin_amdgcn_mfma_f32_16x16x32_bf16(bk.v, uv.v, z[jt] * gam[jt], 0, 0, 0);
      }
      if (c + 1 < nchl) CS_LOADOPS(smem + slot * CS_SLOT)
      slot = (slot + 1 == CS_RING) ? 0 : slot + 1;
      { const unsigned y01 = pk_bf16(y[0], y[1]), y23 = pk_bf16(y[2], y[3]); yo[0] = (u16)y01; yo[512] = (u16)(y01 >> 16); yo[1024] = (u16)y23; yo[1536] = (u16)(y23 >> 16); }
      yo += 16 * 512;
      asm volatile("s_waitcnt lgkmcnt(0)\n\ts_barrier" ::: "memory");
    }
    __builtin_amdgcn_s_setprio(0);
  } else {
    const int hw = wid - 1;
    const size_t ibase = (size_t)bh * CS_NCH;
#define CS_DMA(SRC, DSTOFF) __builtin_amdgcn_global_load_lds((const unsigned*)(SRC), (__attribute__((address_space(3))) unsigned*)(slot_ + (DSTOFF) + lane * 16), 16, 0, 0)
#define CS_ISSUE(C, SLOT) { const size_t item_ = ibase + (C); const u16* g_ = p.sc + ((size_t)bh * SEQ + (size_t)(C) * 16) * 64 + lane * 8; char* slot_ = smem + (SLOT) * CS_SLOT; \
      if (hw == 0) { CS_DMA(g_ + 0 * SCN, 0); CS_DMA(g_ + 0 * SCN + 512, 1024); CS_DMA(g_ + 2 * SCN, 4096); CS_DMA(p.exy0 + item_ * 1024 + lane * 8, 9216); if (lane < 32) CS_DMA(g_ + 4 * SCN + it * 256, 8192); } \
      else if (hw == 1) { CS_DMA(g_ + 1 * SCN, 2048); CS_DMA(g_ + 1 * SCN + 512, 3072); CS_DMA(g_ + 2 * SCN + 512, 5120); CS_DMA(p.exy0 + item_ * 1024 + 512 + lane * 8, 10240); if (lane < 32) CS_DMA(g_ + 5 * SCN + it * 256, 8704); } \
      else { CS_DMA(g_ + 3 * SCN, 6144); CS_DMA(g_ + 3 * SCN + 512, 7168); if (lane < 16) CS_DMA(p.exg + item_ * 64 + lane * 4, 11264); } }
#define CS_WAITBAR(N5, N3) { if (hw < 2) asm volatile("s_waitcnt vmcnt(" #N5 ")\n\ts_barrier" ::: "memory"); else asm volatile("s_waitcnt vmcnt(" #N3 ")\n\ts_barrier" ::: "memory"); }
    CS_ISSUE(c_lo + 0, 0) CS_ISSUE(c_lo + 1, 1) CS_ISSUE(c_lo + 2, 2) CS_ISSUE(c_lo + 3, 3)
    CS_WAITBAR(10, 6)
    int slot = 4;
    for (int c = 0; c < nchl; ++c) {
      if (c + 4 < nchl) {
        CS_ISSUE(c_lo + c + 4, slot)
        slot = (slot + 1 == CS_RING) ? 0 : slot + 1;
        CS_WAITBAR(10, 6)
      } else {
        const int n = nchl - 3 - c;
        if (n >= 1) CS_WAITBAR(5, 3)
        else CS_WAITBAR(0, 0)
      }
    }
  }
}

__device__ __forceinline__ void attn_items(const Params& p, int l, int vb, int nvb, char* smem) {
  const int tid = threadIdx.x, lane = tid & 63, wid = tid >> 6, fr = lane & 15, fq = lane >> 4;
  char* sK = smem;
  char* sV = smem + 32768;
  u16* ycat = p.h;
  for (int item = vb; item < 2048; item += nvb) {
    const int head = item & 7, blk = (item >> 3) & 63, b = item >> 9, kvh = head >> 2;
    const int t0 = blk * 128;
    __syncthreads();
#pragma unroll
    for (int i = 0; i < 8; ++i) {
      const int id = tid + 256 * i;
      {
        const int key = id >> 3, chk = id & 7;
        const int t = t0 - 128 + key;
        uint4 v = make_uint4(0, 0, 0, 0);
        if (t >= 0) v = *(const uint4*)(p.projR + ((size_t)b * SEQ + t) * RW + R_KA + kvh * 64 + chk * 8);
        *(uint4*)(sK + key * 128 + ((chk ^ ((key >> 1) & 7)) << 4)) = v;
      }
      {
        const int d = id >> 5, chk = id & 31;
        const int t = t0 - 128 + chk * 8;
        uint4 v = make_uint4(0, 0, 0, 0);
        if (t >= 0) v = *(const uint4*)(p.vT + ((size_t)((b * 2 + kvh) * 64 + d)) * SEQ + t);
        *(uint4*)(sV + d * 528 + chk * 16) = v;
      }
    }
    __syncthreads();
    const int q0 = wid * 32;
    bf16x8 qf[2][2];
#pragma unroll
    for (int qt = 0; qt < 2; ++qt)
#pragma unroll
      for (int ks = 0; ks < 2; ++ks)
        qf[qt][ks] = *(const bf16x8*)(p.projR + ((size_t)b * SEQ + t0 + q0 + qt * 16 + fr) * RW + R_Q + head * 64 + ks * 32 + fq * 8);
    f32x4 acc[16][2];
#pragma unroll
    for (int kt = 0; kt < 16; ++kt) { acc[kt][0] = (f32x4){0.f, 0.f, 0.f, 0.f}; acc[kt][1] = (f32x4){0.f, 0.f, 0.f, 0.f}; }
#pragma unroll
    for (int kt = 0; kt < 16; ++kt)
#pragma unroll
      for (int ks = 0; ks < 2; ++ks) {
        const bf16x8 kf = *(const bf16x8*)(sK + (kt * 16 + fr) * 128 + (((ks * 4 + fq) ^ ((fr >> 1) & 7)) << 4));
        acc[kt][0] = __builtin_amdgcn_mfma_f32_16x16x32_bf16(kf, qf[0][ks], acc[kt][0], 0, 0, 0);
        acc[kt][1] = __builtin_amdgcn_mfma_f32_16x16x32_bf16(kf, qf[1][ks], acc[kt][1], 0, 0, 0);
      }
    const float sink = p.sinks[l * 8 + head];
    float inv[2];
#pragma unroll
    for (int qt = 0; qt < 2; ++qt) {
      const int qi = q0 + qt * 16 + fr;
      float m = sink;
#pragma unroll
      for (int kt = 0; kt < 16; ++kt)
#pragma unroll
        for (int j = 0; j < 4; ++j) {
          const int si = kt * 16 + fq * 4 + j;
          const bool ok = (si > qi) && (si <= qi + 128) && (blk > 0 || si >= 128);
          const float s = ok ? acc[kt][qt][j] * 0.125f : -INFINITY;
          acc[kt][qt][j] = s; m = fmaxf(m, s);
        }
      m = fmaxf(m, __shfl_xor(m, 16)); m = fmaxf(m, __shfl_xor(m, 32));
      float sum = 0.f;
#pragma unroll
      for (int kt = 0; kt < 16; ++kt)
#pragma unroll
        for (int j = 0; j < 4; ++j) { const float pv = __expf(acc[kt][qt][j] - m); acc[kt][qt][j] = pv; sum += pv; }
      sum += __shfl_xor(sum, 16); sum += __shfl_xor(sum, 32);
      inv[qt] = 1.0f / (sum + __expf(sink - m));
    }
    f32x4 o[4][2];
#pragma unroll
    for (int dt = 0; dt < 4; ++dt) { o[dt][0] = (f32x4){0.f, 0.f, 0.f, 0.f}; o[dt][1] = (f32x4){0.f, 0.f, 0.f, 0.f}; }
#pragma unroll
    for (int kk = 0; kk < 8; ++kk) {
      bf16x8 pf[2];
#pragma unroll
      for (int qt = 0; qt < 2; ++qt) {
        union { unsigned u[4]; bf16x8 v; } cv;
        cv.u[0] = pk_bf16(acc[2 * kk][qt][0], acc[2 * kk][qt][1]); cv.u[1] = pk_bf16(acc[2 * kk][qt][2], acc[2 * kk][qt][3]);
        cv.u[2] = pk_bf16(acc[2 * kk + 1][qt][0], acc[2 * kk + 1][qt][1]); cv.u[3] = pk_bf16(acc[2 * kk + 1][qt][2], acc[2 * kk + 1][qt][3]);
        pf[qt] = cv.v;
      }
#pragma unroll
      for (int dt = 0; dt < 4; ++dt) {
        union { uint2 h[2]; bf16x8 v; } vv;
        const char* vr = sV + (dt * 16 + fr) * 528 + (kk * 32 + fq * 4) * 2;
        vv.h[0] = *(const uint2*)vr; vv.h[1] = *(const uint2*)(vr + 32);
        o[dt][0] = __builtin_amdgcn_mfma_f32_16x16x32_bf16(vv.v, pf[0], o[dt][0], 0, 0, 0);
        o[dt][1] = __builtin_amdgcn_mfma_f32_16x16x32_bf16(vv.v, pf[1], o[dt][1], 0, 0, 0);
      }
    }
#pragma unroll
    for (int qt = 0; qt < 2; ++qt) {
      const size_t tok = (size_t)b * SEQ + t0 + q0 + qt * 16 + fr;
#pragma unroll
      for (int dt = 0; dt < 4; ++dt) {
        const int d = head * 64 + dt * 16 + fq * 4;
        const uint2 g = *(const uint2*)(p.projR + tok * RW + R_GA + d);
        const float g0 = bf_lo(g.x), g1 = bf_hi(g.x), g2 = bf_lo(g.y), g3 = bf_hi(g.y);
        const float v0 = o[dt][qt][0] * inv[qt] * siluf_(g0), v1 = o[dt][qt][1] * inv[qt] * siluf_(g1);
        const float v2 = o[dt][qt][2] * inv[qt] * siluf_(g2), v3 = o[dt][qt][3] * inv[qt] * siluf_(g3);
        *(uint2*)(ycat + tok * DM + 512 + d) = make_uint2(pk_bf16(v0, v1), pk_bf16(v2, v3));
      }
    }
  }
}

__device__ __forceinline__ void mixA_phase(const Params& p, int l, char* smem, f32x4 (&z)[4]) {
  const int nb = gridDim.x;
  if (nb > 128) {
    if ((int)blockIdx.x < 128) chunkscan_block(p, blockIdx.x, smem, 0, 256, z);
    else {
      chunkprep_phase(p, smem, 256, 8, blockIdx.x - 128, nb - 128);
    }
  } else {
    if (l == 0) weight_jobs(p, 1, blockIdx.x, nb, smem);
    for (int cb = blockIdx.x; cb < 128; cb += nb) { __syncthreads(); f32x4 zl[4]; chunkscan_block(p, cb, smem, 0, 512, zl); }
  }
}
__device__ __forceinline__ void mixB_phase(const Params& p, int l, char* smem, f32x4 (&z)[4]) {
  const int nb = gridDim.x;
  if (nb > 128) {
    if ((int)blockIdx.x < 128) chunkscan_block(p, blockIdx.x, smem, 256, 256, z);
    else {
      if (l == 0) weight_jobs(p, 1, blockIdx.x - 128, nb - 128, smem);
      attn_items(p, l, blockIdx.x - 128, nb - 128, smem);
    }
  } else attn_items(p, l, blockIdx.x, nb, smem);
}

__device__ __forceinline__ void post_phase(const Params& p, int l) {
  const float* gw = p.gn_w + l * 512; const float* gb = p.gn_b + l * 512;
  const u16* s_v = p.sc + 5 * SCN;
  u16* ycat = p.h;
  const int nthreads = gridDim.x * 256;
  for (int idx = blockIdx.x * 256 + threadIdx.x; idx < (NTOK / 4) * 128; idx += nthreads) {
    const int tok = (idx >> 7) * 4, c4 = (idx & 127) * 4, head = c4 >> 6;
    const int b = tok >> 13, t = tok & (SEQ - 1);
    f32x4 y[4];
#pragma unroll
    for (int r = 0; r < 4; ++r) { const uint2 yy = *(const uint2*)((const u16*)p.yraw + (size_t)(tok + r) * 512 + c4); y[r] = (f32x4){bf_lo(yy.x), bf_hi(yy.x), bf_lo(yy.y), bf_hi(yy.y)}; }
    const size_t so = ((size_t)(b * 8 + head) * SEQ + t);
    const u16* vch = s_v + (so & ~(size_t)15) * 64;
    const u16* vp = vch + ((((c4 & 63) >> 4) * 64 + (((t & 15) >> 2) << 4) + (c4 & 15)) * 4);
    uint2 ve[4];
#pragma unroll
    for (int j = 0; j < 4; ++j) ve[j] = *(const uint2*)(vp + j * 4);
    const f32x4 rk4 = *(const f32x4*)(p.rk + so);
    uint2 gg[4];
#pragma unroll
    for (int r = 0; r < 4; ++r) gg[r] = *(const uint2*)(p.projR + (size_t)(tok + r) * RW + R_G + c4);
    const f32x4 gwv = *(const f32x4*)(gw + c4), gbv = *(const f32x4*)(gb + c4);
#pragma unroll
    for (int r = 0; r < 4; ++r) {
      float s = (y[r][0] + y[r][1]) + (y[r][2] + y[r][3]);
      s += __shfl_xor(s, 1); s += __shfl_xor(s, 2); s += __shfl_xor(s, 4); s += __shfl_xor(s, 8);
      const float mean = s * (1.0f / 64.0f);
      const f32x4 d = y[r] - mean;
      float q = d[0] * d[0] + d[1] * d[1] + d[2] * d[2] + d[3] * d[3];
      q += __shfl_xor(q, 1); q += __shfl_xor(q, 2); q += __shfl_xor(q, 4); q += __shfl_xor(q, 8);
      const float rstd = rsqrtf(q * (1.0f / 64.0f) + 64e-5f);
      float v[4];
#pragma unroll
      for (int j = 0; j < 4; ++j) { const unsigned w = (r < 2) ? ve[j].x : ve[j].y; v[j] = (r & 1) ? bf_hi(w) : bf_lo(w); }
      const float g[4] = {bf_lo(gg[r].x), bf_hi(gg[r].x), bf_lo(gg[r].y), bf_hi(gg[r].y)};
      float o[4];
#pragma unroll
      for (int j = 0; j < 4; ++j) o[j] = (d[j] * rstd * gwv[j] + gbv[j] + rk4[r] * v[j]) * siluf_(g[j]);
      *(uint2*)(ycat + (size_t)(tok + r) * DM + c4) = make_uint2(pk_bf16(o[0], o[1]), pk_bf16(o[2], o[3]));
    }
  }
}

__global__ void __launch_bounds__(256, 2) mega(Params p, int ph_begin, int ph_end) {
  __shared__ __attribute__((aligned(16))) char smem[SMEM_BYTES];
  __shared__ __attribute__((aligned(16))) unsigned xb_st[4];
  if (p.never) cg::this_grid().sync();
  const unsigned xcc = xb_xcc_id();
  if (threadIdx.x == 0) { xb_st[0] = 0u; xb_st[1] = 0u; if (ph_end - ph_begin > 1) (void)xb_add(&p.bar[XB_XCNT(xcc)], 1u); }
  __syncthreads();
#define RUN_PHASE(K, STMT) if (ph_begin <= (K) && (K) < ph_end) { STMT; if ((K) + 1 < ph_end) { grid_barrier(p.bar, xcc, xb_st); } }
  const bool split = gridDim.x > 128;
  f32x4 zst[4];
#pragma unroll
  for (int jt = 0; jt < 4; ++jt) zst[jt] = (f32x4){0.f, 0.f, 0.f, 0.f};
  RUN_PHASE(0, phase0(p, smem))
  RUN_PHASE(1, gemm_phase<1>(p, p.h, p.WinT, nullptr, 27, smem))
  RUN_PHASE(2, prep_phase(p, 0, smem))
  RUN_PHASE(3, chunkprep_phase(p, smem, 0, split ? 8 : 9, blockIdx.x, gridDim.x))
  RUN_PHASE(4, mixA_phase(p, 0, smem, zst))
  RUN_PHASE(5, mixB_phase(p, 0, smem, zst))
  RUN_PHASE(6, post_phase(p, 0))
  RUN_PHASE(7, gemm_phase<2>(p, p.h, p.WoutT, p.x, 8, smem))
  RUN_PHASE(8, norm_rows_bf16(p.out, p.norm_gain + DM, p.h))
  RUN_PHASE(9, gemm_phase<1>(p, p.h, p.WinT + (size_t)INW * DM, nullptr, 27, smem))
  RUN_PHASE(10, prep_phase(p, 1, smem))
  RUN_PHASE(11, chunkprep_phase(p, smem, 0, split ? 8 : 9, blockIdx.x, gridDim.x))
  RUN_PHASE(12, mixA_phase(p, 1, smem, zst))
  RUN_PHASE(13, mixB_phase(p, 1, smem, zst))
  RUN_PHASE(14, post_phase(p, 1))
  RUN_PHASE(15, gemm_phase<2>(p, p.h, p.WoutT + (size_t)DM * DM, p.out, 8, smem))
  RUN_PHASE(16, norm_rows_f32_inplace(p.out, p.final_gain))
}

extern "C" void kernel_launch(void* const* d_in, const int* in_sizes, int n_in, void* d_out, int out_size, void* d_ws, size_t ws_size, hipStream_t stream) {
  Params p{};
  p.x = (const float*)d_in[0]; p.norm_gain = (const float*)d_in[1]; p.w_in = (const float*)d_in[2]; p.shift_mu = (const float*)d_in[3];
  p.w0 = (const float*)d_in[4]; p.w_up = (const float*)d_in[5]; p.a0 = (const float*)d_in[6]; p.a_up = (const float*)d_in[7];
  p.k_k = (const float*)d_in[8]; p.k_a = (const float*)d_in[9]; p.r_k = (const float*)d_in[10]; p.gn_w = (const float*)d_in[11];
  p.gn_b = (const float*)d_in[12]; p.sinks = (const float*)d_in[13]; p.w_out = (const float*)d_in[14]; p.final_gain = (const float*)d_in[15];
  p.out = (float*)d_out;
  char* w = (char*)d_ws; size_t off = 0;
  auto take = [&](size_t bytes) { char* r = w + off; off += (bytes + 255) & ~(size_t)255; return r; };
  p.bar = (unsigned*)take(16384);
  p.WinT = (u16*)take((size_t)2 * INW * DM * 2);
  p.WoutT = (u16*)take((size_t)2 * DM * DM * 2);
  p.WupT = (u16*)take((size_t)2 * 512 * 64 * 2);
  p.AupT = (u16*)take((size_t)2 * 512 * 64 * 2);
  p.h = (u16*)take((size_t)NTOK * DM * 2);
  p.projS = (u16*)take((size_t)NTOK * SHW * 2);
  p.yraw = (float*)p.projS;
  p.exy0 = (u16*)((char*)p.projS + (size_t)NTOK * 512 * 4);
  p.exg = (float*)((char*)p.projS + (size_t)NTOK * 512 * 4 + (size_t)16384 * 1024 * 2);
  p.projR = (u16*)take((size_t)NTOK * RW * 2);
  p.vT = (u16*)take((size_t)4 * 2 * 64 * SEQ * 2);
  p.sc = (u16*)take((size_t)6 * SCN * 2);
  p.rk = (float*)take((size_t)NTOK * 8 * 4);
  p.never = 0; p.pad = 0;
  static int grid_blocks = 0;
  if (!grid_blocks) {
    int dev = 0, cus = 0, per_cu = 0;
    hipGetDevice(&dev);
    hipDeviceGetAttribute(&cus, hipDeviceAttributeMultiprocessorCount, dev);
    hipOccupancyMaxActiveBlocksPerMultiprocessor(&per_cu, mega, 256, 0);
    if (per_cu > 2) per_cu = 2;
    if (per_cu < 1) per_cu = 1;
    grid_blocks = cus * per_cu;
  }
  hipMemsetAsync(p.bar, 0, 16384, stream);
#if MULTI_LAUNCH
  for (int ph = 0; ph < NPHASE; ++ph) {
    hipLaunchKernelGGL(mega, dim3(grid_blocks), dim3(256), 0, stream, p, ph, ph + 1);
  }
#else
  int b = 0, e = NPHASE;
  void* args[] = {&p, &b, &e};
  hipError_t err = hipLaunchCooperativeKernel((void*)mega, dim3(grid_blocks), dim3(256), args, 0, stream);
  if (err != hipSuccess) fprintf(stderr, "cooperative launch failed: %s (grid %d)\n", hipGetErrorString(err), grid_blocks);
#endif
}
```

```cpp
#include <hip/hip_runtime.h>
#include <hip/hip_cooperative_groups.h>
#include <cstdio>
#include <cstdint>
namespace cg = cooperative_groups;

#ifndef MULTI_LAUNCH
#define MULTI_LAUNCH 0
#endif

typedef unsigned short u16;
typedef short bf16x8 __attribute__((ext_vector_type(8)));
typedef float f32x4 __attribute__((ext_vector_type(4)));

#define SEQ 8192
#define NTOK 32768
#define DM 1024
#define INW 3456
#define SHW 1664
#define RW 1792
#define C_R 0
#define C_K 512
#define C_V 1024
#define C_WD 1536
#define C_AD 1600
#define R_G 0
#define R_Q 512
#define R_KA 1024
#define R_GA 1280
#define SCN ((size_t)NTOK * 512)
#define SMEM_BYTES 66560
#define NPHASE 17

struct Params {
  const float *x, *norm_gain, *w_in, *shift_mu, *w0, *w_up, *a0, *a_up, *k_k, *k_a, *r_k, *gn_w, *gn_b, *sinks, *w_out, *final_gain;
  float* out;
  unsigned* bar;
  u16 *WinT, *WoutT, *WupT, *AupT, *h, *projS, *projR, *vT, *sc;
  float *yraw, *rk, *exg;
  u16* exy0;
  int never; int pad;
};

typedef float f32x2_t __attribute__((ext_vector_type(2)));
typedef __bf16 bf16x2_t __attribute__((ext_vector_type(2)));
__device__ __forceinline__ unsigned pk_bf16(float lo, float hi) {
  f32x2_t v = {lo, hi};
  bf16x2_t b = __builtin_convertvector(v, bf16x2_t);
  return __builtin_bit_cast(unsigned, b);
}
__device__ __forceinline__ u16 f2bf(float f) { return (u16)(pk_bf16(f, 0.f) & 0xffffu); }
__device__ __forceinline__ float bf_lo(unsigned u) { return __uint_as_float(u << 16); }
__device__ __forceinline__ float bf_hi(unsigned u) { return __uint_as_float(u & 0xffff0000u); }
__device__ __forceinline__ float sigmoidf_(float x) { return __builtin_amdgcn_rcpf(1.0f + __expf(-x)); }
__device__ __forceinline__ float siluf_(float x) { return x * __builtin_amdgcn_rcpf(1.0f + __expf(-x)); }
__device__ __forceinline__ float tanhf_(float x) { float t = __expf(2.0f * x); return 1.0f - 2.0f * __builtin_amdgcn_rcpf(t + 1.0f); }
template <int CTRL> __device__ __forceinline__ float dpp_mov(float x) {
  return __int_as_float(__builtin_amdgcn_update_dpp(0, __float_as_int(x), CTRL, 0xf, 0xf, false));
}
__device__ __forceinline__ float row16_sum(float x) {
  x += dpp_mov<0xB1>(x);
  x += dpp_mov<0x4E>(x);
  x += dpp_mov<0x141>(x);
  x += dpp_mov<0x140>(x);
  return x;
}
__device__ __forceinline__ float wave_sum(float x) {
#pragma unroll
  for (int o = 32; o > 0; o >>= 1) x += __shfl_xor(x, o);
  return x;
}

typedef unsigned u32x4 __attribute__((ext_vector_type(4)));
typedef unsigned u32x2 __attribute__((ext_vector_type(2)));
__device__ __forceinline__ u32x2 gload8_async(const void* ptr) {
  u32x2 r; asm volatile("global_load_dwordx2 %0, %1, off" : "=v"(r) : "v"(ptr) : "memory"); return r;
}
__device__ __forceinline__ u32x4 gload16_async(const void* ptr) {
  u32x4 r; asm volatile("global_load_dwordx4 %0, %1, off" : "=v"(r) : "v"(ptr) : "memory"); return r;
}
#define XB_TMO      128
#define XB_XCNT(j)  (256  + 64 * (j))
#define XB_XSUB(j)  (1280 + 64 * (j))
#define XB_XGEN(j)  (2304 + 64 * (j))
#define XB_TOP      3328
#define XB_TOPGEN   3392
#define XCD_BAR_WORDS 3456
#define XB_SPIN_CAP (1u << 22)
__device__ __forceinline__ unsigned xb_ld(unsigned* p)              { return __hip_atomic_load(p, __ATOMIC_RELAXED, __HIP_MEMORY_SCOPE_AGENT); }
__device__ __forceinline__ unsigned xb_add(unsigned* p, unsigned v) { return __hip_atomic_fetch_add(p, v, __ATOMIC_RELAXED, __HIP_MEMORY_SCOPE_AGENT); }
__device__ __forceinline__ unsigned xb_xcc_id() { return (unsigned)__builtin_amdgcn_s_getreg((3 << 11) | 20) & 0xFu; }
#define XB_SPIN(cond, bar) do { unsigned _sp = 0; while (cond) { __builtin_amdgcn_s_sleep(1); \
    if ((++_sp & 255u) == 0u) { if (xb_ld(&(bar)[XB_TMO])) break; if (_sp > XB_SPIN_CAP) { atomicAdd(&(bar)[XB_TMO], 1u); break; } } } } while (0)
__device__ __forceinline__ void xcd_barrier_complete(unsigned* bar, unsigned x, unsigned& nloc, unsigned& nx) {
  const unsigned G = gridDim.x;
  unsigned sum, cnt, mine, sp = 0u;
  for (;;) {
    sum = 0u; cnt = 0u; mine = 0u;
#pragma unroll
    for (unsigned j = 0; j < 16; ++j) { const unsigned c = xb_ld(&bar[XB_XCNT(j)]); sum += c; cnt += (c > 0u) ? 1u : 0u; mine = (j == x) ? c : mine; }
    if (sum == G) break;
    __builtin_amdgcn_s_sleep(1);
    if ((++sp & 255u) == 0u) { if (xb_ld(&bar[XB_TMO])) break; if (sp > XB_SPIN_CAP) { atomicAdd(&bar[XB_TMO], 1u); break; } }
  }
  nloc = mine > 0u ? mine : 1u; nx = cnt > 0u ? cnt : 1u;
}
__device__ __forceinline__ void grid_barrier(unsigned* bar, unsigned x, volatile unsigned* st) {
  asm volatile("s_waitcnt vmcnt(0)" ::: "memory");
  __syncthreads();
  if (threadIdx.x == 0) {
    __builtin_amdgcn_s_waitcnt(0);
    unsigned nloc = st[0], nx = st[1];
    if (nloc == 0u) { xcd_barrier_complete(bar, x, nloc, nx); st[0] = nloc; st[1] = nx; }
    const unsigned old = xb_add(&bar[XB_XSUB(x)], 1u);
    const unsigned gen = old / nloc;
    if (old + 1u == (gen + 1u) * nloc) {
      __builtin_amdgcn_fence(__ATOMIC_RELEASE, "agent");
      asm volatile("s_waitcnt vmcnt(0)" ::: "memory");
      const unsigned og = xb_add(&bar[XB_TOP], 1u);
      const unsigned tg = og / nx;
      if (og + 1u == (tg + 1u) * nx) xb_add(&bar[XB_TOPGEN], 1u);
      else XB_SPIN(xb_ld(&bar[XB_TOPGEN]) == tg, bar);
      __builtin_amdgcn_fence(__ATOMIC_ACQUIRE, "agent");
      xb_add(&bar[XB_XGEN(x)], 1u);
      asm volatile("s_waitcnt vmcnt(0)" ::: "memory");
    } else {
      XB_SPIN(xb_ld(&bar[XB_XGEN(x)]) == gen, bar);
      __builtin_amdgcn_fence(__ATOMIC_ACQUIRE, "agent");
      asm volatile("s_waitcnt vmcnt(0)" ::: "memory");
    }
  }
  __syncthreads();
}

__device__ void transpose_tile(const float* __restrict__ src, int ld_src, u16* __restrict__ dst, int ld_dst, int k0, int n0, float* tile, bool perm) {
  const int tid = threadIdx.x;
  {
    const int r0 = tid >> 4, c4 = (tid & 15) * 4;
#pragma unroll
    for (int i = 0; i < 4; ++i) {
      const int r = r0 + 16 * i;
      const f32x4 v = *(const f32x4*)(src + (size_t)(k0 + r) * ld_src + n0 + c4);
      tile[r * 65 + c4] = v[0]; tile[r * 65 + c4 + 1] = v[1]; tile[r * 65 + c4 + 2] = v[2]; tile[r * 65 + c4 + 3] = v[3];
    }
  }
  __syncthreads();
  {
    const int k8 = (tid & 7) * 8;
#pragma unroll
    for (int i = 0; i < 2; ++i) {
      const int nn = (tid >> 3) + 32 * i;
      const int col = perm ? (((nn & 15) >> 2) * 16 + (nn >> 4) * 4 + (nn & 3)) : nn;
      unsigned w[4];
#pragma unroll
      for (int e = 0; e < 4; ++e) w[e] = pk_bf16(tile[(k8 + 2 * e) * 65 + col], tile[(k8 + 2 * e + 1) * 65 + col]);
      *(uint4*)(dst + (size_t)(n0 + nn) * ld_dst + k0 + k8) = make_uint4(w[0], w[1], w[2], w[3]);
    }
  }
  __syncthreads();
}

__device__ void norm_rows_bf16(const float* __restrict__ src, const float* __restrict__ gain, u16* __restrict__ dst) {
  const int lane = threadIdx.x & 63;
  const int gw = blockIdx.x * 4 + (threadIdx.x >> 6), nw = gridDim.x * 4;
  f32x4 g[4];
#pragma unroll
  for (int i = 0; i < 4; ++i) g[i] = *(const f32x4*)(gain + i * 256 + lane * 4);
  for (int row = gw; row < NTOK; row += nw) {
    const float* s = src + (size_t)row * DM;
    f32x4 v[4]; float ss = 0.f;
#pragma unroll
    for (int i = 0; i < 4; ++i) { v[i] = *(const f32x4*)(s + i * 256 + lane * 4); ss += v[i][0] * v[i][0] + v[i][1] * v[i][1] + v[i][2] * v[i][2] + v[i][3] * v[i][3]; }
    ss = wave_sum(ss);
    const float rstd = rsqrtf(ss * (1.0f / DM) + 1e-5f);
#pragma unroll
    for (int i = 0; i < 4; ++i) {
      uint2 o; o.x = pk_bf16(v[i][0] * rstd * g[i][0], v[i][1] * rstd * g[i][1]); o.y = pk_bf16(v[i][2] * rstd * g[i][2], v[i][3] * rstd * g[i][3]);
      *(uint2*)(dst + (size_t)row * DM + i * 256 + lane * 4) = o;
    }
  }
}

__device__ void norm_rows_f32_inplace(float* __restrict__ buf, const float* __restrict__ gain) {
  const int lane = threadIdx.x & 63;
  const int gw = blockIdx.x * 4 + (threadIdx.x >> 6), nw = gridDim.x * 4;
  f32x4 g[4];
#pragma unroll
  for (int i = 0; i < 4; ++i) g[i] = *(const f32x4*)(gain + i * 256 + lane * 4);
  for (int row = gw; row < NTOK; row += nw) {
    float* s = buf + (size_t)row * DM;
    f32x4 v[4]; float ss = 0.f;
#pragma unroll
    for (int i = 0; i < 4; ++i) { v[i] = *(const f32x4*)(s + i * 256 + lane * 4); ss += v[i][0] * v[i][0] + v[i][1] * v[i][1] + v[i][2] * v[i][2] + v[i][3] * v[i][3]; }
    ss = wave_sum(ss);
    const float rstd = rsqrtf(ss * (1.0f / DM) + 1e-5f);
#pragma unroll
    for (int i = 0; i < 4; ++i) { f32x4 o = v[i] * rstd * g[i]; *(f32x4*)(s + i * 256 + lane * 4) = o; }
  }
}

__device__ __forceinline__ void weight_jobs(const Params& p, int l, int vb, int nvb, char* smem) {
  float* tile = (float*)smem;
  const int J_WIN = 16 * 54, J_WOUT = 16 * 16, J_UP = 8;
  const int total = J_WIN + J_WOUT + 2 * J_UP;
  for (int job = vb; job < total; job += nvb) {
    if (job < J_WIN) {
      int kt = job / 54, nt = job % 54;
      transpose_tile(p.w_in + (size_t)l * DM * INW, INW, p.WinT + (size_t)l * INW * DM, DM, kt * 64, nt * 64, tile, true);
    } else if (job < J_WIN + J_WOUT) {
      int r = job - J_WIN; int kt = r / 16, nt = r % 16;
      transpose_tile(p.w_out + (size_t)l * DM * DM, DM, p.WoutT + (size_t)l * DM * DM, DM, kt * 64, nt * 64, tile, true);
    } else if (job < J_WIN + J_WOUT + J_UP) {
      int nt = job - J_WIN - J_WOUT;
      transpose_tile(p.w_up + (size_t)l * 64 * 512, 512, p.WupT + (size_t)l * 512 * 64, 64, 0, nt * 64, tile, false);
    } else {
      int nt = job - J_WIN - J_WOUT - J_UP;
      transpose_tile(p.a_up + (size_t)l * 64 * 512, 512, p.AupT + (size_t)l * 512 * 64, 64, 0, nt * 64, tile, false);
    }
  }
}
__device__ __forceinline__ void phase0(const Params& p, char* smem) {
  weight_jobs(p, 0, blockIdx.x, gridDim.x, smem);
  if (gridDim.x <= 64) { }
  norm_rows_bf16(p.x, p.norm_gain, p.h);
}

template <int MODE, bool SWAP>
__device__ __forceinline__ void gemm_tile(const Params& p, const u16* __restrict__ A, const u16* __restrict__ Bt, const float* __restrict__ xold, int m0, int n0, char* smem,
                                          bool staged, bool has_next, int nm0, int nn0) {
  const int tid = threadIdx.x, lane = tid & 63, wid = tid >> 6, wr = wid >> 1, wc = wid & 1, fr = lane & 15, fq = lane >> 4;
  f32x4 acc[4][4];
#pragma unroll
  for (int i = 0; i < 4; ++i)
#pragma unroll
    for (int j = 0; j < 4; ++j) acc[i][j] = (f32x4){0.f, 0.f, 0.f, 0.f};
  const int r8 = lane >> 3, cs = lane & 7;
  const int frsw = (fr >> 1) & 7;
  const u16* gA[4]; const u16* gB[4];
#pragma unroll
  for (int i = 0; i < 4; ++i) {
    const int row = wid * 32 + i * 8 + r8;
    const int c = cs ^ ((row >> 1) & 7);
    gA[i] = A + (size_t)(m0 + row) * DM + c * 8;
    gB[i] = Bt + (size_t)(n0 + row) * DM + c * 8;
  }
  char* lds_w = smem + wid * 4096 + lane * 16;
#define GEMM_STAGE(BUF, KT) { _Pragma("unroll") for (int i = 0; i < 4; ++i) { \
      __builtin_amdgcn_global_load_lds((const unsigned*)(gA[i] + (KT) * 64), (__attribute__((address_space(3))) unsigned*)(lds_w + (BUF) * 32768 + i * 1024), 16, 0, 0); \
      __builtin_amdgcn_global_load_lds((const unsigned*)(gB[i] + (KT) * 64), (__attribute__((address_space(3))) unsigned*)(lds_w + (BUF) * 32768 + 16384 + i * 1024), 16, 0, 0); } }
  if (!staged) GEMM_STAGE(0, 0)
  asm volatile("s_waitcnt vmcnt(0)" ::: "memory");
  __syncthreads();
  const unsigned lds0 = (unsigned)(size_t)(__attribute__((address_space(3))) char*)smem;
  const unsigned a_rd = lds0 + (wr * 64 + fr) * 128, b_rd = lds0 + 16384 + (wc * 64 + fr) * 128;
  const unsigned cof0 = ((0 * 4 + fq) ^ frsw) << 4, cof1 = ((1 * 4 + fq) ^ frsw) << 4;
#define DS_RD(DST, ADDR, OFF) asm volatile("ds_read_b128 %0, %1 offset:" #OFF : "=v"(DST) : "v"(ADDR))
#define WAIT_LGKM_TIED(N, F) asm volatile("s_waitcnt lgkmcnt(" #N ")" : "+v"(F##a[0]), "+v"(F##a[1]), "+v"(F##a[2]), "+v"(F##a[3]), "+v"(F##b[0]), "+v"(F##b[1]), "+v"(F##b[2]), "+v"(F##b[3]))
  for (int kt = 0; kt < 16; ++kt) {
    if (kt < 15) GEMM_STAGE((kt + 1) & 1, kt + 1)
    else if (has_next) {
#pragma unroll
      for (int i = 0; i < 4; ++i) {
        const int row = wid * 32 + i * 8 + r8;
        const int c = cs ^ ((row >> 1) & 7);
        __builtin_amdgcn_global_load_lds((const unsigned*)(A + (size_t)(nm0 + row) * DM + c * 8), (__attribute__((address_space(3))) unsigned*)(lds_w + i * 1024), 16, 0, 0);
        __builtin_amdgcn_global_load_lds((const unsigned*)(Bt + (size_t)(nn0 + row) * DM + c * 8), (__attribute__((address_space(3))) unsigned*)(lds_w + 16384 + i * 1024), 16, 0, 0);
      }
    }
    const unsigned bo = (kt & 1) * 32768;
    bf16x8 f0a[4], f0b[4], f1a[4], f1b[4];
    {
      const unsigned aa0 = a_rd + bo + cof0, ab0 = b_rd + bo + cof0, aa1 = a_rd + bo + cof1, ab1 = b_rd + bo + cof1;
      DS_RD(f0a[0], aa0, 0); DS_RD(f0a[1], aa0, 2048); DS_RD(f0a[2], aa0, 4096); DS_RD(f0a[3], aa0, 6144);
      DS_RD(f0b[0], ab0, 0); DS_RD(f0b[1], ab0, 2048); DS_RD(f0b[2], ab0, 4096); DS_RD(f0b[3], ab0, 6144);
      DS_RD(f1a[0], aa1, 0); DS_RD(f1a[1], aa1, 2048); DS_RD(f1a[2], aa1, 4096); DS_RD(f1a[3], aa1, 6144);
      DS_RD(f1b[0], ab1, 0); DS_RD(f1b[1], ab1, 2048); DS_RD(f1b[2], ab1, 4096); DS_RD(f1b[3], ab1, 6144);
    }
    WAIT_LGKM_TIED(8, f0);
#pragma unroll
    for (int mi = 0; mi < 4; ++mi)
#pragma unroll
      for (int ni = 0; ni < 4; ++ni) {
        if (SWAP) acc[mi][ni] = __builtin_amdgcn_mfma_f32_16x16x32_bf16(f0a[mi], f0b[ni], acc[mi][ni], 0, 0, 0);
        else      acc[mi][ni] = __builtin_amdgcn_mfma_f32_16x16x32_bf16(f0b[ni], f0a[mi], acc[mi][ni], 0, 0, 0);
      }
    WAIT_LGKM_TIED(0, f1);
#pragma unroll
    for (int mi = 0; mi < 4; ++mi)
#pragma unroll
      for (int ni = 0; ni < 4; ++ni) {
        if (SWAP) acc[mi][ni] = __builtin_amdgcn_mfma_f32_16x16x32_bf16(f1a[mi], f1b[ni], acc[mi][ni], 0, 0, 0);
        else      acc[mi][ni] = __builtin_amdgcn_mfma_f32_16x16x32_bf16(f1b[ni], f1a[mi], acc[mi][ni], 0, 0, 0);
      }
    if (kt < 15) {
      asm volatile("s_waitcnt vmcnt(0)" : "+v"(acc[0][0]), "+v"(acc[0][1]), "+v"(acc[0][2]), "+v"(acc[0][3]), "+v"(acc[1][0]), "+v"(acc[1][1]), "+v"(acc[1][2]), "+v"(acc[1][3]),
                   "+v"(acc[2][0]), "+v"(acc[2][1]), "+v"(acc[2][2]), "+v"(acc[2][3]), "+v"(acc[3][0]), "+v"(acc[3][1]), "+v"(acc[3][2]), "+v"(acc[3][3]) :: "memory");
      __syncthreads();
    }
  }
  if (MODE == 1) {
    if (!SWAP) {
      u16* base; int ld, nb;
      if (n0 < SHW) { base = p.projS; ld = SHW; nb = n0; } else { base = p.projR; ld = RW; nb = n0 - SHW; }
#pragma unroll
      for (int mi = 0; mi < 4; ++mi) {
        const int m = m0 + wr * 64 + mi * 16 + fr;
#pragma unroll
        for (int hp = 0; hp < 2; ++hp) {
          const int n = nb + wc * 64 + fq * 16 + hp * 8;
          uint4 o; o.x = pk_bf16(acc[mi][2 * hp][0], acc[mi][2 * hp][1]); o.y = pk_bf16(acc[mi][2 * hp][2], acc[mi][2 * hp][3]);
          o.z = pk_bf16(acc[mi][2 * hp + 1][0], acc[mi][2 * hp + 1][1]); o.w = pk_bf16(acc[mi][2 * hp + 1][2], acc[mi][2 * hp + 1][3]);
          *(uint4*)(base + (size_t)m * ld + n) = o;
        }
      }
    } else {
      const int b = m0 >> 13;
#pragma unroll
      for (int mi = 0; mi < 4; ++mi) {
        const int t = (m0 & (SEQ - 1)) + wr * 64 + mi * 16 + fq * 4;
#pragma unroll
        for (int ni = 0; ni < 4; ++ni) {
          const int nn = wc * 64 + (fr >> 2) * 16 + ni * 4 + (fr & 3);
          uint2 o; o.x = pk_bf16(acc[mi][ni][0], acc[mi][ni][1]); o.y = pk_bf16(acc[mi][ni][2], acc[mi][ni][3]);
          *(uint2*)(p.vT + ((size_t)(b * 128 + nn)) * SEQ + t) = o;
        }
      }
    }
  } else {
#pragma unroll
    for (int mi = 0; mi < 4; ++mi) {
      const int m = m0 + wr * 64 + mi * 16 + fr;
#pragma unroll
      for (int ni = 0; ni < 4; ++ni) {
        const int n = n0 + wc * 64 + fq * 16 + ni * 4;
        f32x4 xo = *(const f32x4*)(xold + (size_t)m * DM + n);
        *(f32x4*)(p.out + (size_t)m * DM + n) = xo + acc[mi][ni];
      }
    }
  }
}

template <int MODE>
__device__ __forceinline__ void gemm_phase(const Params& p, const u16* A, const u16* Bt, const float* xold, int ntn, char* smem) {
  const int total = 256 * ntn;
  bool staged = false;
  for (int t = blockIdx.x; t < total; t += gridDim.x) {
    const int x = t & 7, i = t >> 3;
    const int mg = i / (8 * ntn), rem = i % (8 * ntn), nt = rem >> 3, mi = rem & 7;
    const int mt = x * 32 + mg * 8 + mi;
    const int t2 = t + gridDim.x;
    const bool has_next = t2 < total;
    const int i2 = t2 >> 3, mg2 = i2 / (8 * ntn), rem2 = i2 % (8 * ntn);
    const int nm0 = ((t2 & 7) * 32 + mg2 * 8 + (rem2 & 7)) * 128, nn0 = (rem2 >> 3) * 128;
    if (MODE == 1 && nt == 22) gemm_tile<MODE, true>(p, A, Bt, xold, mt * 128, nt * 128, smem, staged, has_next, nm0, nn0);
    else gemm_tile<MODE, false>(p, A, Bt, xold, mt * 128, nt * 128, smem, staged, has_next, nm0, nn0);
    staged = has_next;
  }
  asm volatile("s_waitcnt vmcnt(0)" ::: "memory");
  __syncthreads();
}

__device__ __forceinline__ void prep_phase(const Params& p, int l, char* smem) {
  const int tid = threadIdx.x, lane = tid & 63, wid = tid >> 6, fr = lane & 15, fq = lane >> 4;
  const float* mu = p.shift_mu + l * SHW;
  const u16* wupT = p.WupT + (size_t)l * 512 * 64;
  const u16* aupT = p.AupT + (size_t)l * 512 * 64;
  const float* w0 = p.w0 + l * 512; const float* a0 = p.a0 + l * 512;
  const float* kkw = p.k_k + l * 512; const float* kaw = p.k_a + l * 512; const float* rkw = p.r_k + l * 512;
  u16* s_nkk = p.sc; u16* s_e = p.sc + SCN; u16* s_b = p.sc + 2 * SCN; u16* s_kp = p.sc + 3 * SCN; u16* s_r = p.sc + 4 * SCN; u16* s_v = p.sc + 5 * SCN;
  float* lp = (float*)(smem + 16384);
  {
#pragma unroll
    for (int i = 0; i < 4; ++i) {
      const int e = (tid + 256 * i) * 4;
      const int arr = e >> 9, c = e & 511;
      const float* srcp = arr < 3 ? (mu + arr * 512 + c) : arr == 3 ? (w0 + c) : arr == 4 ? (a0 + c) : arr == 5 ? (kkw + c) : arr == 6 ? (kaw + c) : (rkw + c);
      *(f32x4*)(lp + e) = *(const f32x4*)srcp;
    }
  }
  __syncthreads();
  for (int tile = blockIdx.x; tile < 512; tile += gridDim.x) {
    const int tok0 = tile * 64;
    {
      const int tk = tid >> 2, part = tid & 3;
      const int tok = tok0 + tk;
      const bool first = (tok & (SEQ - 1)) == 0;
      const u16* cur = p.projS + (size_t)tok * SHW;
#pragma unroll
      for (int which = 0; which < 2; ++which) {
        const int col = (which ? C_AD : C_WD) + part * 16;
        uint4 c0 = *(const uint4*)(cur + col), c1 = *(const uint4*)(cur + col + 8);
        uint4 p0 = make_uint4(0, 0, 0, 0), p1 = make_uint4(0, 0, 0, 0);
        if (!first) { p0 = *(const uint4*)(cur - SHW + col); p1 = *(const uint4*)(cur - SHW + col + 8); }
        unsigned cu[8] = {c0.x, c0.y, c0.z, c0.w, c1.x, c1.y, c1.z, c1.w};
        unsigned pu[8] = {p0.x, p0.y, p0.z, p0.w, p1.x, p1.y, p1.z, p1.w};
        unsigned ou[8];
#pragma unroll
        for (int i = 0; i < 8; ++i) {
          float ca = bf_lo(cu[i]), cb = bf_hi(cu[i]), pa = bf_lo(pu[i]), pb = bf_hi(pu[i]);
          float xa = ca + (pa - ca) * mu[col + 2 * i], xb = cb + (pb - cb) * mu[col + 2 * i + 1];
          if (which == 0) { xa = tanhf_(xa); xb = tanhf_(xb); }
          ou[i] = pk_bf16(xa, xb);
        }
        const int sw = (tk >> 1) & 7;
        char* dst = smem + which * 8192 + tk * 128;
        *(uint4*)(dst + (((part * 2) ^ sw) << 4)) = make_uint4(ou[0], ou[1], ou[2], ou[3]);
        *(uint4*)(dst + (((part * 2 + 1) ^ sw) << 4)) = make_uint4(ou[4], ou[5], ou[6], ou[7]);
      }
    }
    __syncthreads();
    bf16x8 wfr[2][4], afr[2][4];
#pragma unroll 1
    for (int hq = 0; hq < 8; ++hq) {
      const int hh = hq >> 2, mq = hq & 3;
      const int head = wid * 2 + hh;
      if (mq == 0) {
#pragma unroll
        for (int ks = 0; ks < 2; ++ks)
#pragma unroll
          for (int ni = 0; ni < 4; ++ni) {
            const int n = head * 64 + (fr >> 2) * 16 + ni * 4 + (fr & 3);
            wfr[ks][ni] = *(const bf16x8*)(wupT + n * 64 + ks * 32 + fq * 8);
            afr[ks][ni] = *(const bf16x8*)(aupT + n * 64 + ks * 32 + fq * 8);
          }
      }
      f32x4 aw[4][1], aa[4][1];
#pragma unroll
      for (int i = 0; i < 4; ++i) { aw[i][0] = (f32x4){0.f, 0.f, 0.f, 0.f}; aa[i][0] = (f32x4){0.f, 0.f, 0.f, 0.f}; }
#pragma unroll
      for (int ks = 0; ks < 2; ++ks) {
        const int coff = ((ks * 4 + fq) ^ ((fr >> 1) & 7)) << 4;
        const bf16x8 xw = *(const bf16x8*)(smem + (mq * 16 + fr) * 128 + coff);
        const bf16x8 xa = *(const bf16x8*)(smem + 8192 + (mq * 16 + fr) * 128 + coff);
#pragma unroll
        for (int ni = 0; ni < 4; ++ni) {
          aw[ni][0] = __builtin_amdgcn_mfma_f32_16x16x32_bf16(wfr[ks][ni], xw, aw[ni][0], 0, 0, 0);
          aa[ni][0] = __builtin_amdgcn_mfma_f32_16x16x32_bf16(afr[ks][ni], xa, aa[ni][0], 0, 0, 0);
        }
      }
#pragma unroll
      for (int mi = 0; mi < 1; ++mi) {
        const int tok = tok0 + mq * 16 + fr;
        const bool first = (tok & (SEQ - 1)) == 0;
        const int b = tok >> 13, t = tok & (SEQ - 1);
        const u16* cur = p.projS + (size_t)tok * SHW;
        const size_t obase = ((size_t)(b * 8 + head) * SEQ + t) * 64;
        float kkv[4][4], al[4][4];
        float ssq = 0.f, rks = 0.f;
#pragma unroll
        for (int hp = 0; hp < 2; ++hp) {
          const int cb8 = head * 64 + fq * 16 + hp * 8;
          const uint4 cr4 = *(const uint4*)(cur + C_R + cb8), ck4 = *(const uint4*)(cur + C_K + cb8), cv4 = *(const uint4*)(cur + C_V + cb8);
          uint4 pr4 = make_uint4(0, 0, 0, 0), pk4 = make_uint4(0, 0, 0, 0), pv4 = make_uint4(0, 0, 0, 0);
          if (!first) { pr4 = *(const uint4*)(cur - SHW + C_R + cb8); pk4 = *(const uint4*)(cur - SHW + C_K + cb8); pv4 = *(const uint4*)(cur - SHW + C_V + cb8); }
          unsigned ro_[4], ko_[4], vo_[4], eo_[4];
#pragma unroll
          for (int q = 0; q < 2; ++q) {
            const int ni = hp * 2 + q, cb = cb8 + q * 4;
            const uint2 cr = q ? make_uint2(cr4.z, cr4.w) : make_uint2(cr4.x, cr4.y), ck = q ? make_uint2(ck4.z, ck4.w) : make_uint2(ck4.x, ck4.y), cv = q ? make_uint2(cv4.z, cv4.w) : make_uint2(cv4.x, cv4.y);
            const uint2 pr = q ? make_uint2(pr4.z, pr4.w) : make_uint2(pr4.x, pr4.y), pk = q ? make_uint2(pk4.z, pk4.w) : make_uint2(pk4.x, pk4.y), pv = q ? make_uint2(pv4.z, pv4.w) : make_uint2(pv4.x, pv4.y);
            const f32x4 mr = *(const f32x4*)(lp + 0 * 512 + cb), mk = *(const f32x4*)(lp + 1 * 512 + cb), mv = *(const f32x4*)(lp + 2 * 512 + cb);
            const f32x4 w0v = *(const f32x4*)(lp + 3 * 512 + cb), a0v = *(const f32x4*)(lp + 4 * 512 + cb), kkc = *(const f32x4*)(lp + 5 * 512 + cb), kac = *(const f32x4*)(lp + 6 * 512 + cb), rkc = *(const f32x4*)(lp + 7 * 512 + cb);
            float rc[4] = {bf_lo(cr.x), bf_hi(cr.x), bf_lo(cr.y), bf_hi(cr.y)}, rp[4] = {bf_lo(pr.x), bf_hi(pr.x), bf_lo(pr.y), bf_hi(pr.y)};
            float kc[4] = {bf_lo(ck.x), bf_hi(ck.x), bf_lo(ck.y), bf_hi(ck.y)}, kp_[4] = {bf_lo(pk.x), bf_hi(pk.x), bf_lo(pk.y), bf_hi(pk.y)};
            float vc[4] = {bf_lo(cv.x), bf_hi(cv.x), bf_lo(cv.y), bf_hi(cv.y)}, vp[4] = {bf_lo(pv.x), bf_hi(pv.x), bf_lo(pv.y), bf_hi(pv.y)};
            float ro[4], ko[4], vo[4], eo[4];
#pragma unroll
            for (int j = 0; j < 4; ++j) {
              const float r = rc[j] + (rp[j] - rc[j]) * mr[j];
              const float k = kc[j] + (kp_[j] - kc[j]) * mk[j];
              const float v = vc[j] + (vp[j] - vc[j]) * mv[j];
              const float a = sigmoidf_(a0v[j] + aa[ni][mi][j]);
              const float e = 0.60653066f * sigmoidf_(w0v[j] + aw[ni][mi][j]);
              const float kk = k * kkc[j];
              const float kpr = k * (1.0f + (a - 1.0f) * kac[j]);
              ssq += kk * kk; rks += r * kpr * rkc[j];
              kkv[ni][j] = kk; al[ni][j] = a;
              ro[j] = r; ko[j] = kpr; vo[j] = v; eo[j] = e;
            }
            ro_[2 * q] = pk_bf16(ro[0], ro[1]); ro_[2 * q + 1] = pk_bf16(ro[2], ro[3]);
            ko_[2 * q] = pk_bf16(ko[0], ko[1]); ko_[2 * q + 1] = pk_bf16(ko[2], ko[3]);
            vo_[2 * q] = pk_bf16(vo[0], vo[1]); vo_[2 * q + 1] = pk_bf16(vo[2], vo[3]);
            eo_[2 * q] = pk_bf16(eo[0], eo[1]); eo_[2 * q + 1] = pk_bf16(eo[2], eo[3]);
          }
          const size_t o = obase + fq * 16 + hp * 8;
          *(uint4*)(s_r + o) = make_uint4(ro_[0], ro_[1], ro_[2], ro_[3]);
          *(uint4*)(s_kp + o) = make_uint4(ko_[0], ko_[1], ko_[2], ko_[3]);
          *(uint4*)(s_v + o) = make_uint4(vo_[0], vo_[1], vo_[2], vo_[3]);
          *(uint4*)(s_e + o) = make_uint4(eo_[0], eo_[1], eo_[2], eo_[3]);
        }
        ssq += __shfl_xor(ssq, 16); ssq += __shfl_xor(ssq, 32);
        rks += __shfl_xor(rks, 16); rks += __shfl_xor(rks, 32);
        const float inv = 1.0f / fmaxf(sqrtf(ssq), 1e-12f);
#pragma unroll
        for (int hp = 0; hp < 2; ++hp) {
          const size_t o = obase + fq * 16 + hp * 8;
          unsigned nn_[4], bb_[4];
#pragma unroll
          for (int q = 0; q < 2; ++q) {
            const int ni = hp * 2 + q;
            const float n0_ = kkv[ni][0] * inv, n1 = kkv[ni][1] * inv, n2 = kkv[ni][2] * inv, n3 = kkv[ni][3] * inv;
            nn_[2 * q] = pk_bf16(-n0_, -n1); nn_[2 * q + 1] = pk_bf16(-n2, -n3);
            bb_[2 * q] = pk_bf16(n0_ * al[ni][0], n1 * al[ni][1]); bb_[2 * q + 1] = pk_bf16(n2 * al[ni][2], n3 * al[ni][3]);
          }
          *(uint4*)(s_nkk + o) = make_uint4(nn_[0], nn_[1], nn_[2], nn_[3]);
          *(uint4*)(s_b + o) = make_uint4(bb_[0], bb_[1], bb_[2], bb_[3]);
        }
        if (fq == 0) p.rk[(size_t)(b * 8 + head) * SEQ + t] = rks;
      }
    }
    __syncthreads();
  }
}

typedef float f32x2 __attribute__((ext_vector_type(2)));
#define SCH 16
#define NPR 8
#define OPB_F (9 * NPR * 64)
__device__ __forceinline__ f32x2 lo2(f32x4 v) { return (f32x2){v[0], v[1]}; }
__device__ __forceinline__ f32x2 hi2(f32x4 v) { return (f32x2){v[2], v[3]}; }
__device__ void scan_block(const Params& p, int sb, char* smem) {
  const int tid = threadIdx.x, lane = tid & 63, wid = tid >> 6;
  const int bh = sb >> 3, r8 = sb & 7;
  const int b = bh >> 3, head = bh & 7;
  float* opb = (float*)smem;
  float* scb = opb + 2 * OPB_F;
  float* vb = scb + 2 * NPR * 4;
  float* yb = vb + 2 * 8 * SCH;
  const size_t base = (size_t)bh * SEQ * 64;
  constexpr int NCH = SEQ / SCH;
  if (wid < 2) {
    __builtin_amdgcn_s_setprio(3);
    const int rg = lane >> 4, c = lane & 15, rowl = wid * 4 + rg;
    f32x2 S01 = {0.f, 0.f}, S23 = {0.f, 0.f};
    __syncthreads();
    for (int ch = 0; ch < NCH; ++ch) {
      const f32x4* o4 = (const f32x4*)(opb + (ch & 1) * OPB_F) + c;
      const f32x4* s4 = (const f32x4*)(scb + (ch & 1) * NPR * 4);
      const f32x4* v4 = (const f32x4*)(vb + (ch & 1) * 8 * SCH + rowl * SCH);
      float* ypart = yb + (ch & 1) * (SCH * 128) + rowl * 16 + c;
      f32x4 A1 = o4[0 * 128], A2 = o4[1 * 128], R1 = o4[2 * 128], D12 = o4[3 * 128], B1 = o4[4 * 128], K1 = o4[5 * 128], b2 = o4[6 * 128], k2 = o4[7 * 128], r2 = o4[8 * 128], cs = s4[0];
      f32x4 vq[4];
#pragma unroll
      for (int i = 0; i < 4; ++i) vq[i] = v4[i];
#pragma unroll
      for (int j = 0; j < NPR; ++j) {
        const f32x4 A1n = o4[0 * 128 + (j + 1) * 16], A2n = o4[1 * 128 + (j + 1) * 16], R1n = o4[2 * 128 + (j + 1) * 16], D12n = o4[3 * 128 + (j + 1) * 16], B1n = o4[4 * 128 + (j + 1) * 16],
                    K1n = o4[5 * 128 + (j + 1) * 16], b2n = o4[6 * 128 + (j + 1) * 16], k2n = o4[7 * 128 + (j + 1) * 16], r2n = o4[8 * 128 + (j + 1) * 16], csn = s4[j + 1];
        asm volatile("" ::: "memory");
        const float v1 = vq[j >> 1][(2 * j) & 3], v2 = vq[j >> 1][(2 * j + 1) & 3];
        f32x2 t1 = S01 * lo2(A1); t1 = __builtin_elementwise_fma(S23, hi2(A1), t1);
        f32x2 t2 = S01 * lo2(A2); t2 = __builtin_elementwise_fma(S23, hi2(A2), t2);
        f32x2 t3 = S01 * lo2(R1); t3 = __builtin_elementwise_fma(S23, hi2(R1), t3);
        float p1 = t1[0] + t1[1], p2 = t2[0] + t2[1], q1 = t3[0] + t3[1];
        p1 = row16_sum(p1); p2 = row16_sum(p2);
        const float u1 = p1;
        const float u2 = fmaf(u1, cs[0], fmaf(v1, cs[1], p2));
        ypart[(2 * j) * 128] = fmaf(u1, cs[2], fmaf(v1, cs[3], q1));
        const f32x2 u1v = {u1, u1}, v1v = {v1, v1}, u2v = {u2, u2}, v2v = {v2, v2};
        S01 = S01 * lo2(D12); S23 = S23 * hi2(D12);
        S01 = __builtin_elementwise_fma(u1v, lo2(B1), S01); S23 = __builtin_elementwise_fma(u1v, hi2(B1), S23);
        S01 = __builtin_elementwise_fma(v1v, lo2(K1), S01); S23 = __builtin_elementwise_fma(v1v, hi2(K1), S23);
        S01 = __builtin_elementwise_fma(u2v, lo2(b2), S01); S23 = __builtin_elementwise_fma(u2v, hi2(b2), S23);
        S01 = __builtin_elementwise_fma(v2v, lo2(k2), S01); S23 = __builtin_elementwise_fma(v2v, hi2(k2), S23);
        f32x2 t4 = S01 * lo2(r2); t4 = __builtin_elementwise_fma(S23, hi2(r2), t4);
        ypart[(2 * j + 1) * 128] = t4[0] + t4[1];
        A1 = A1n; A2 = A2n; R1 = R1n; D12 = D12n; B1 = B1n; K1 = K1n; b2 = b2n; k2 = k2n; r2 = r2n; cs = csn;
      }
      __syncthreads();
    }
    __builtin_amdgcn_s_setprio(0);
  } else {
    const int ht = tid - 128;
    const int pr = ht >> 4, cg = ht & 15;
    const int st = ht >> 3, vrow = ht & 7;
    const u16* gsrc = p.sc + base + (size_t)(2 * pr) * 64 + 4 * cg;
    const u16* vsrc = p.sc + 5 * SCN + base + (size_t)st * 64 + r8 * 8 + vrow;
    uint2 rg0[10], rg1[10]; u16 rv0, rv1;
#define H_LOAD(R, RV, CH) { _Pragma("unroll") for (int a = 0; a < 5; ++a) { R[2 * a] = *(const uint2*)(gsrc + a * SCN + (size_t)(CH) * (SCH * 64)); R[2 * a + 1] = *(const uint2*)(gsrc + a * SCN + (size_t)(CH) * (SCH * 64) + 64); } RV = vsrc[(size_t)(CH) * (SCH * 64)]; }
#define H_UNPK(U) (f32x4){bf_lo((U).x), bf_hi((U).x), bf_lo((U).y), bf_hi((U).y)}
#define H_CONV(R, RV, BUF) { \
      const f32x4 n1 = H_UNPK(R[0]), n2 = H_UNPK(R[1]), e1 = H_UNPK(R[2]), e2 = H_UNPK(R[3]), b1 = H_UNPK(R[4]), b2_ = H_UNPK(R[5]), k1 = H_UNPK(R[6]), k2_ = H_UNPK(R[7]), r1 = H_UNPK(R[8]), r2_ = H_UNPK(R[9]); \
      const f32x4 d1 = (f32x4){__expf(-e1[0]), __expf(-e1[1]), __expf(-e1[2]), __expf(-e1[3])}, d2 = (f32x4){__expf(-e2[0]), __expf(-e2[1]), __expf(-e2[2]), __expf(-e2[3])}; \
      float* ob = opb + (BUF) * OPB_F + pr * 64 + 4 * cg; \
      *(f32x4*)(ob + 0 * 512) = n1; *(f32x4*)(ob + 1 * 512) = d1 * n2; *(f32x4*)(ob + 2 * 512) = d1 * r1; *(f32x4*)(ob + 3 * 512) = d1 * d2; \
      *(f32x4*)(ob + 4 * 512) = b1 * d2; *(f32x4*)(ob + 5 * 512) = k1 * d2; *(f32x4*)(ob + 6 * 512) = b2_; *(f32x4*)(ob + 7 * 512) = k2_; *(f32x4*)(ob + 8 * 512) = r2_; \
      const f32x4 m0 = b1 * n2, m1 = k1 * n2, m2 = b1 * r1, m3 = k1 * r1; \
      float c0 = (m0[0] + m0[1]) + (m0[2] + m0[3]), c1 = (m1[0] + m1[1]) + (m1[2] + m1[3]), c2 = (m2[0] + m2[1]) + (m2[2] + m2[3]), c3 = (m3[0] + m3[1]) + (m3[2] + m3[3]); \
      c0 = row16_sum(c0); c1 = row16_sum(c1); c2 = row16_sum(c2); c3 = row16_sum(c3); \
      if (cg == 0) *(f32x4*)(scb + (BUF) * NPR * 4 + pr * 4) = (f32x4){c0, c1, c2 * 0.0625f, c3 * 0.0625f}; \
      vb[(BUF) * 8 * SCH + vrow * SCH + st] = __uint_as_float(((unsigned)RV) << 16); }
#define H_YRED(CH) { const f32x4* y4 = (const f32x4*)(yb + ((CH) & 1) * (SCH * 128) + st * 128 + vrow * 16); \
      const f32x4 a_ = y4[0] + y4[1], b_ = y4[2] + y4[3]; const f32x4 c_ = a_ + b_; \
      p.yraw[((size_t)b * SEQ + (size_t)(CH) * SCH + st) * 512 + head * 64 + r8 * 8 + vrow] = (c_[0] + c_[1]) + (c_[2] + c_[3]); }
    H_LOAD(rg0, rv0, 0)
    H_LOAD(rg1, rv1, 1)
    H_CONV(rg0, rv0, 0)
    H_LOAD(rg0, rv0, 2)
    __syncthreads();
    for (int ch = 0; ch < NCH; ch += 2) {
      H_CONV(rg1, rv1, 1)
      if (ch + 3 < NCH) H_LOAD(rg1, rv1, ch + 3)
      if (ch >= 1) H_YRED(ch - 1)
      __syncthreads();
      if (ch + 2 < NCH) H_CONV(rg0, rv0, 0)
      if (ch + 4 < NCH) H_LOAD(rg0, rv0, ch + 4)
      H_YRED(ch)
      __syncthreads();
    }
    H_YRED(NCH - 1)
  }
}


#define CP_LD 68
__device__ __forceinline__ void chunkprep_phase(const Params& p, char* smem, int c_lo, int lg, int vb, int nvb) {
  float* fA = (float*)smem;
  float* fR = fA + 16 * CP_LD;
  float* fB = fR + 16 * CP_LD;
  float* fK = fB + 16 * CP_LD;
  float* fV = fK + 16 * CP_LD;
  float* fG = fV + 16 * CP_LD;
  float* fW = fG + 16 * CP_LD;
  float* fM = fW + 16 * CP_LD;
  float* gL = fM + 4 * 256;
  float* mbuf = gL + 64;
  const int tid = threadIdx.x, lane = tid & 63, wid = tid >> 6;
  const int nitems = 32 << lg, cmask = (1 << lg) - 1;
  int nb = 0, first_item = 0;
  u32x2 u[6];
  if (vb < nitems) {
    const int bh0 = vb >> lg, c0 = c_lo + (vb & cmask);
    const u16* src0 = p.sc + ((size_t)bh0 * SEQ + (size_t)c0 * 16) * 64 + (tid >> 4) * 64 + (tid & 15) * 4;
#pragma unroll
    for (int a = 0; a < 6; ++a) u[a] = gload8_async(src0 + a * SCN);
  }
  for (int idx = vb; idx < nitems; idx += nvb) {
    if (nb == 0) first_item = idx;
    const int bh = idx >> lg, c = c_lo + (idx & cmask);
    const int item = bh * 512 + c;
    const size_t goff = ((size_t)bh * SEQ + (size_t)c * 16) * 64;
    {
      const int t = tid >> 4, j4 = (tid & 15) * 4;
      if (idx == vb) asm volatile("s_waitcnt vmcnt(0)" ::: "memory"); else asm volatile("s_waitcnt vmcnt(3)" ::: "memory");
      const int o = t * CP_LD + j4;
      *(f32x4*)(fA + o) = (f32x4){bf_lo(u[0].x), bf_hi(u[0].x), bf_lo(u[0].y), bf_hi(u[0].y)};
      *(f32x4*)(fG + o) = (f32x4){__expf(-bf_lo(u[1].x)), __expf(-bf_hi(u[1].x)), __expf(-bf_lo(u[1].y)), __expf(-bf_hi(u[1].y))};
      *(f32x4*)(fB + o) = (f32x4){bf_lo(u[2].x), bf_hi(u[2].x), bf_lo(u[2].y), bf_hi(u[2].y)};
      *(f32x4*)(fK + o) = (f32x4){bf_lo(u[3].x), bf_hi(u[3].x), bf_lo(u[3].y), bf_hi(u[3].y)};
      *(f32x4*)(fR + o) = (f32x4){bf_lo(u[4].x), bf_hi(u[4].x), bf_lo(u[4].y), bf_hi(u[4].y)};
      *(f32x4*)(fV + o) = (f32x4){bf_lo(u[5].x), bf_hi(u[5].x), bf_lo(u[5].y), bf_hi(u[5].y)};
      const int nidx = idx + nvb;
      if (nidx < nitems) {
        const u16* srcn = p.sc + ((size_t)(nidx >> lg) * SEQ + (size_t)(c_lo + (nidx & cmask)) * 16) * 64 + t * 64 + j4;
        asm volatile("" ::: "memory");
#pragma unroll
        for (int a = 0; a < 6; ++a) u[a] = gload8_async(srcn + a * SCN);
      }
    }
    __syncthreads();
    {
      const int j = tid & 63, part = tid >> 6;
      float g[16];
#pragma unroll
      for (int t = 0; t < 16; ++t) g[t] = fG[t * CP_LD + j];
#pragma unroll
      for (int t = 1; t < 16; ++t) g[t] *= g[t - 1];
      float* arr = part == 0 ? fA : part == 1 ? fR : part == 2 ? fB : fK;
#pragma unroll
      for (int t = 0; t < 16; ++t) {
        const float f = part == 0 ? (t == 0 ? 1.0f : g[t > 0 ? t - 1 : 0]) : part == 1 ? g[t] : __builtin_amdgcn_rcpf(g[t]);
        arr[t * CP_LD + j] *= f;
      }
      if (part == 0) gL[j] = g[15];
    }
    __syncthreads();
    {
      const float* xa = (wid < 2 ? fA : fR) + (lane & 15) * CP_LD + (lane >> 4);
      const float* xb = ((wid & 1) ? fK : fB) + (lane & 15) * CP_LD + (lane >> 4);
      f32x4 acc4[4];
#pragma unroll
      for (int c4 = 0; c4 < 4; ++c4) acc4[c4] = (f32x4){0.f, 0.f, 0.f, 0.f};
#pragma unroll
      for (int ks = 0; ks < 16; ++ks) acc4[ks & 3] = __builtin_amdgcn_mfma_f32_16x16x4f32(xa[ks * 4], xb[ks * 4], acc4[ks & 3], 0, 0, 0);
      const f32x4 acc = (acc4[0] + acc4[1]) + (acc4[2] + acc4[3]);
      const int s2 = lane & 15;
#pragma unroll
      for (int r = 0; r < 4; ++r) {
        const int t = (lane >> 4) * 4 + r;
        const bool keep = wid < 2 ? (s2 < t) : (s2 <= t);
        const float mval = keep ? acc[r] : 0.f;
        fM[wid * 256 + t * 16 + s2] = mval;
        if (wid == 0) mbuf[nb * 256 + t * 16 + s2] = mval;
      }
    }
    __syncthreads();
    {
      const int t = tid >> 4, i4 = (tid & 15) * 4;
      f32x4 acc = (f32x4){0.f, 0.f, 0.f, 0.f};
#pragma unroll
      for (int q = 0; q < 4; ++q) {
        const f32x4 m = *(const f32x4*)(fM + 256 + t * 16 + q * 4);
#pragma unroll
        for (int e = 0; e < 4; ++e) acc += m[e] * *(const f32x4*)(fV + (q * 4 + e) * CP_LD + i4);
      }
      *(f32x4*)(fW + t * CP_LD + i4) = acc;
    }
    __syncthreads();
    {
      const int pz = tid;
      const int hs = pz >> 7, ph = pz & 127;
      {
        const int kk = ph >> 6, ln = ph & 63, t = ln & 15, quad = ln >> 4, j = 32 * kk + quad * 4;
        const float* src = (hs ? fR : fA) + t * CP_LD + j;
        const f32x4 x = *(const f32x4*)src, y = *(const f32x4*)(src + 16);
        *(uint4*)(p.sc + hs * SCN + goff + ph * 8) = make_uint4(pk_bf16(x[0], x[1]), pk_bf16(x[2], x[3]), pk_bf16(y[0], y[1]), pk_bf16(y[2], y[3]));
      }
      {
        const int jt = ph >> 5, ln = (ph & 31) * 2, j = jt * 16 + (ln & 15), quad = ln >> 4;
        const float* src = hs ? fK : fB;
        const float g0 = gL[j], g1 = gL[j + 1];
        float q0[4], q1[4];
#pragma unroll
        for (int r = 0; r < 4; ++r) { q0[r] = src[(quad * 4 + r) * CP_LD + j] * g0; q1[r] = src[(quad * 4 + r) * CP_LD + j + 1] * g1; }
        *(uint4*)(p.sc + (2 + hs) * SCN + goff + ph * 8) = make_uint4(pk_bf16(q0[0], q0[1]), pk_bf16(q0[2], q0[3]), pk_bf16(q1[0], q1[1]), pk_bf16(q1[2], q1[3]));
      }
      {
        const int it = ph >> 5, ln = (ph & 31) * 2, i = it * 16 + (ln & 15), quad = ln >> 4;
        const float* src = hs ? fV : fW;
        float q0[4], q1[4];
#pragma unroll
        for (int r = 0; r < 4; ++r) { q0[r] = src[(quad * 4 + r) * CP_LD + i]; q1[r] = src[(quad * 4 + r) * CP_LD + i + 1]; }
        *(uint4*)(p.sc + (4 + hs) * SCN + goff + ph * 8) = make_uint4(pk_bf16(q0[0], q0[1]), pk_bf16(q0[2], q0[3]), pk_bf16(q1[0], q1[1]), pk_bf16(q1[2], q1[3]));
      }
      if (pz < 64) {
        const int t = pz & 15, quad = pz >> 4;
        const f32x4 x = *(const f32x4*)(fM + 2 * 256 + t * 16 + quad * 4), y = *(const f32x4*)(fM + 3 * 256 + t * 16 + quad * 4);
        *(uint4*)(p.exy0 + (size_t)item * 1024 + 512 + pz * 8) = make_uint4(pk_bf16(x[0], x[1]), pk_bf16(x[2], x[3]), pk_bf16(y[0], y[1]), pk_bf16(y[2], y[3]));
      }
      if (tid < 64) p.exg[(size_t)item * 64 + tid] = gL[tid];
    }
    ++nb;
    const bool last = idx + nvb >= nitems;
    if (nb == 16 || last) {
      __syncthreads();
      const int k = wid * 4 + (lane >> 4), cidx = lane & 15;
      if (k < nb) {
        const float* mb = mbuf + k * 256;
        float T_[16];
#pragma unroll
        for (int t = 0; t < 16; ++t) {
          float acc = (t == cidx) ? 1.0f : 0.0f;
#pragma unroll
          for (int q = 0; q < 4; ++q) {
            if (q * 4 < t) {
              const f32x4 m = *(const f32x4*)(mb + t * 16 + q * 4);
#pragma unroll
              for (int e = 0; e < 4; ++e) { const int s2 = q * 4 + e; if (s2 < t) acc = fmaf(m[e], T_[s2], acc); }
            }
          }
          T_[t] = acc;
        }
        float* tb = mbuf + k * 256;
#pragma unroll
        for (int t = 0; t < 16; ++t) tb[t * 16 + cidx] = T_[t];
        asm volatile("s_waitcnt lgkmcnt(0)" ::: "memory");
        const int kidx = first_item + k * nvb;
        u16* dst = p.exy0 + (size_t)((kidx >> lg) * 512 + c_lo + (kidx & cmask)) * 1024;
#pragma unroll
        for (int q = 0; q < 4; ++q) {
          const int lp = q * 16 + cidx, tq = lp & 15, qd = lp >> 4;
          const f32x4 x = *(const f32x4*)(tb + tq * 16 + qd * 4);
          *(uint4*)(dst + lp * 8) = make_uint4(pk_bf16(x[0], x[1]), pk_bf16(x[2], x[3]), 0u, 0u);
        }
      }
      nb = 0;
    }
    __syncthreads();
  }
}

#define CS_SLOT 11520
#define CS_RING 5
#define CS_NCH 512
__device__ __forceinline__ void chunkscan_block(const Params& p, int cb, char* smem, int c_lo, int nchl, f32x4 (&z)[4]) {
  const int tid = threadIdx.x, lane = tid & 63, wid = tid >> 6;
  const int bh = (cb & 7) * 4 + (cb >> 5), it = (cb >> 3) & 3, b = bh >> 3, head = bh & 7;
  if (wid == 0) {
    __builtin_amdgcn_s_setprio(3);
    const int fr = lane & 15, quad = lane >> 4;
    if (c_lo == 0) {
#pragma unroll
      for (int jt = 0; jt < 4; ++jt) z[jt] = (f32x4){0.f, 0.f, 0.f, 0.f};
    }
    u16* yo = (u16*)p.yraw + ((size_t)b * SEQ + (size_t)c_lo * 16 + quad * 4) * 512 + head * 64 + it * 16 + fr;
    asm volatile("s_waitcnt lgkmcnt(0)\n\ts_barrier" ::: "memory");
#define CS_LOADOPS(SL) { const char* sl_ = (SL); \
      af0 = *(const bf16x8*)(sl_ + lane * 16); af1 = *(const bf16x8*)(sl_ + 1024 + lane * 16); \
      rf0 = *(const bf16x8*)(sl_ + 2048 + lane * 16); rf1 = *(const bf16x8*)(sl_ + 3072 + lane * 16); \
      tf = *(const bf16x8*)(sl_ + 9216 + lane * 16); mf = *(const bf16x8*)(sl_ + 10240 + lane * 16); \
      xx = *(const uint2*)(sl_ + 8192 + lane * 8); vv = *(const uint2*)(sl_ + 8704 + lane * 8); \
      _Pragma("unroll") for (int jt = 0; jt < 4; ++jt) { gam[jt] = *(const f32x4*)(sl_ + 11264 + (jt * 16 + quad * 4) * 4); \
        bkl[jt] = *(const uint2*)(sl_ + 4096 + (jt * 64 + lane) * 8); bkh[jt] = *(const uint2*)(sl_ + 6144 + (jt * 64 + lane) * 8); } }
    bf16x8 af0, af1, rf0, rf1, tf, mf; uint2 xx, vv; f32x4 gam[4]; uint2 bkl[4], bkh[4];
    CS_LOADOPS(smem)
    int slot = 1;
    for (int c = 0; c < nchl; ++c) {
      union { unsigned u[4]; bf16x8 v; } zb0, zb1;
      zb0.u[0] = pk_bf16(z[0][0], z[0][1]); zb0.u[1] = pk_bf16(z[0][2], z[0][3]); zb0.u[2] = pk_bf16(z[1][0], z[1][1]); zb0.u[3] = pk_bf16(z[1][2], z[1][3]);
      zb1.u[0] = pk_bf16(z[2][0], z[2][1]); zb1.u[1] = pk_bf16(z[2][2], z[2][3]); zb1.u[2] = pk_bf16(z[3][0], z[3][1]); zb1.u[3] = pk_bf16(z[3][2], z[3][3]);
      f32x4 u0 = (f32x4){bf_lo(xx.x), bf_hi(xx.x), bf_lo(xx.y), bf_hi(xx.y)}, y = (f32x4){0.f, 0.f, 0.f, 0.f};
      u0 = __builtin_amdgcn_mfma_f32_16x16x32_bf16(af0, zb0.v, u0, 0, 0, 0);
      y = __builtin_amdgcn_mfma_f32_16x16x32_bf16(rf0, zb0.v, y, 0, 0, 0);
      u0 = __builtin_amdgcn_mfma_f32_16x16x32_bf16(af1, zb1.v, u0, 0, 0, 0);
      y = __builtin_amdgcn_mfma_f32_16x16x32_bf16(rf1, zb1.v, y, 0, 0, 0);
      union { unsigned u[4]; bf16x8 v; } ub, uv;
      ub.u[0] = pk_bf16(u0[0], u0[1]); ub.u[1] = pk_bf16(u0[2], u0[3]); ub.u[2] = 0u; ub.u[3] = 0u;
      const f32x4 u = __builtin_amdgcn_mfma_f32_16x16x32_bf16(tf, ub.v, (f32x4){0.f, 0.f, 0.f, 0.f}, 0, 0, 0);
      uv.u[0] = pk_bf16(u[0], u[1]); uv.u[1] = pk_bf16(u[2], u[3]); uv.u[2] = vv.x; uv.u[3] = vv.y;
      y = __builtin_amdgcn_mfma_f32_16x16x32_bf16(mf, uv.v, y, 0, 0, 0);
#pragma unroll
      for (int jt = 0; jt < 4; ++jt) {
        union { uint2 h[2]; bf16x8 v; } bk;
        bk.h[0] = bkl[jt]; bk.h[1] = bkh[jt];
        z[jt] = __builtin_amdgcn_mfma_f32_16x16x32_bf16(bk.v, uv.v, z[jt] * gam[jt], 0, 0, 0);
      }
      if (c + 1 < nchl) CS_LOADOPS(smem + slot * CS_SLOT)
      slot = (slot + 1 == CS_RING) ? 0 : slot + 1;
      { const unsigned y01 = pk_bf16(y[0], y[1]), y23 = pk_bf16(y[2], y[3]); yo[0] = (u16)y01; yo[512] = (u16)(y01 >> 16); yo[1024] = (u16)y23; yo[1536] = (u16)(y23 >> 16); }
      yo += 16 * 512;
      asm volatile("s_waitcnt lgkmcnt(0)\n\ts_barrier" ::: "memory");
    }
    __builtin_amdgcn_s_setprio(0);
  } else {
    const int hw = wid - 1;
    const size_t ibase = (size_t)bh * CS_NCH;
#define CS_DMA(SRC, DSTOFF) __builtin_amdgcn_global_load_lds((const unsigned*)(SRC), (__attribute__((address_space(3))) unsigned*)(slot_ + (DSTOFF) + lane * 16), 16, 0, 0)
#define CS_ISSUE(C, SLOT) { const size_t item_ = ibase + (C); const u16* g_ = p.sc + ((size_t)bh * SEQ + (size_t)(C) * 16) * 64 + lane * 8; char* slot_ = smem + (SLOT) * CS_SLOT; \
      if (hw == 0) { CS_DMA(g_ + 0 * SCN, 0); CS_DMA(g_ + 0 * SCN + 512, 1024); CS_DMA(g_ + 2 * SCN, 4096); CS_DMA(p.exy0 + item_ * 1024 + lane * 8, 9216); if (lane < 32) CS_DMA(g_ + 4 * SCN + it * 256, 8192); } \
      else if (hw == 1) { CS_DMA(g_ + 1 * SCN, 2048); CS_DMA(g_ + 1 * SCN + 512, 3072); CS_DMA(g_ + 2 * SCN + 512, 5120); CS_DMA(p.exy0 + item_ * 1024 + 512 + lane * 8, 10240); if (lane < 32) CS_DMA(g_ + 5 * SCN + it * 256, 8704); } \
      else { CS_DMA(g_ + 3 * SCN, 6144); CS_DMA(g_ + 3 * SCN + 512, 7168); if (lane < 16) CS_DMA(p.exg + item_ * 64 + lane * 4, 11264); } }
#define CS_WAITBAR(N5, N3) { if (hw < 2) asm volatile("s_waitcnt vmcnt(" #N5 ")\n\ts_barrier" ::: "memory"); else asm volatile("s_waitcnt vmcnt(" #N3 ")\n\ts_barrier" ::: "memory"); }
    CS_ISSUE(c_lo + 0, 0) CS_ISSUE(c_lo + 1, 1) CS_ISSUE(c_lo + 2, 2) CS_ISSUE(c_lo + 3, 3)
    CS_WAITBAR(10, 6)
    int slot = 4;
    for (int c = 0; c < nchl; ++c) {
      if (c + 4 < nchl) {
        CS_ISSUE(c_lo + c + 4, slot)
        slot = (slot + 1 == CS_RING) ? 0 : slot + 1;
        CS_WAITBAR(10, 6)
      } else {
        const int n = nchl - 3 - c;
        if (n >= 1) CS_WAITBAR(5, 3)
        else CS_WAITBAR(0, 0)
      }
    }
  }
}

__device__ __forceinline__ void attn_items(const Params& p, int l, int vb, int nvb, char* smem) {
  const int tid = threadIdx.x, lane = tid & 63, wid = tid >> 6, fr = lane & 15, fq = lane >> 4;
  char* sK = smem;
  char* sV = smem + 32768;
  u16* ycat = p.h;
  for (int item = vb; item < 2048; item += nvb) {
    const int head = item & 7, blk = (item >> 3) & 63, b = item >> 9, kvh = head >> 2;
    const int t0 = blk * 128;
    __syncthreads();
#pragma unroll
    for (int i = 0; i < 8; ++i) {
      const int id = tid + 256 * i;
      {
        const int key = id >> 3, chk = id & 7;
        const int t = t0 - 128 + key;
        uint4 v = make_uint4(0, 0, 0, 0);
        if (t >= 0) v = *(const uint4*)(p.projR + ((size_t)b * SEQ + t) * RW + R_KA + kvh * 64 + chk * 8);
        *(uint4*)(sK + key * 128 + ((chk ^ ((key >> 1) & 7)) << 4)) = v;
      }
      {
        const int d = id >> 5, chk = id & 31;
        const int t = t0 - 128 + chk * 8;
        uint4 v = make_uint4(0, 0, 0, 0);
        if (t >= 0) v = *(const uint4*)(p.vT + ((size_t)((b * 2 + kvh) * 64 + d)) * SEQ + t);
        *(uint4*)(sV + d * 528 + chk * 16) = v;
      }
    }
    __syncthreads();
    const int q0 = wid * 32;
    bf16x8 qf[2][2];
#pragma unroll
    for (int qt = 0; qt < 2; ++qt)
#pragma unroll
      for (int ks = 0; ks < 2; ++ks)
        qf[qt][ks] = *(const bf16x8*)(p.projR + ((size_t)b * SEQ + t0 + q0 + qt * 16 + fr) * RW + R_Q + head * 64 + ks * 32 + fq * 8);
    f32x4 acc[16][2];
#pragma unroll
    for (int kt = 0; kt < 16; ++kt) { acc[kt][0] = (f32x4){0.f, 0.f, 0.f, 0.f}; acc[kt][1] = (f32x4){0.f, 0.f, 0.f, 0.f}; }
#pragma unroll
    for (int kt = 0; kt < 16; ++kt)
#pragma unroll
      for (int ks = 0; ks < 2; ++ks) {
        const bf16x8 kf = *(const bf16x8*)(sK + (kt * 16 + fr) * 128 + (((ks * 4 + fq) ^ ((fr >> 1) & 7)) << 4));
        acc[kt][0] = __builtin_amdgcn_mfma_f32_16x16x32_bf16(kf, qf[0][ks], acc[kt][0], 0, 0, 0);
        acc[kt][1] = __builtin_amdgcn_mfma_f32_16x16x32_bf16(kf, qf[1][ks], acc[kt][1], 0, 0, 0);
      }
    const float sink = p.sinks[l * 8 + head];
    float inv[2];
#pragma unroll
    for (int qt = 0; qt < 2; ++qt) {
      const int qi = q0 + qt * 16 + fr;
      float m = sink;
#pragma unroll
      for (int kt = 0; kt < 16; ++kt)
#pragma unroll
        for (int j = 0; j < 4; ++j) {
          const int si = kt * 16 + fq * 4 + j;
          const bool ok = (si > qi) && (si <= qi + 128) && (blk > 0 || si >= 128);
          const float s = ok ? acc[kt][qt][j] * 0.125f : -INFINITY;
          acc[kt][qt][j] = s; m = fmaxf(m, s);
        }
      m = fmaxf(m, __shfl_xor(m, 16)); m = fmaxf(m, __shfl_xor(m, 32));
      float sum = 0.f;
#pragma unroll
      for (int kt = 0; kt < 16; ++kt)
#pragma unroll
        for (int j = 0; j < 4; ++j) { const float pv = __expf(acc[kt][qt][j] - m); acc[kt][qt][j] = pv; sum += pv; }
      sum += __shfl_xor(sum, 16); sum += __shfl_xor(sum, 32);
      inv[qt] = 1.0f / (sum + __expf(sink - m));
    }
    f32x4 o[4][2];
#pragma unroll
    for (int dt = 0; dt < 4; ++dt) { o[dt][0] = (f32x4){0.f, 0.f, 0.f, 0.f}; o[dt][1] = (f32x4){0.f, 0.f, 0.f, 0.f}; }
#pragma unroll
    for (int kk = 0; kk < 8; ++kk) {
      bf16x8 pf[2];
#pragma unroll
      for (int qt = 0; qt < 2; ++qt) {
        union { unsigned u[4]; bf16x8 v; } cv;
        cv.u[0] = pk_bf16(acc[2 * kk][qt][0], acc[2 * kk][qt][1]); cv.u[1] = pk_bf16(acc[2 * kk][qt][2], acc[2 * kk][qt][3]);
        cv.u[2] = pk_bf16(acc[2 * kk + 1][qt][0], acc[2 * kk + 1][qt][1]); cv.u[3] = pk_bf16(acc[2 * kk + 1][qt][2], acc[2 * kk + 1][qt][3]);
        pf[qt] = cv.v;
      }
#pragma unroll
      for (int dt = 0; dt < 4; ++dt) {
        union { uint2 h[2]; bf16x8 v; } vv;
        const char* vr = sV + (dt * 16 + fr) * 528 + (kk * 32 + fq * 4) * 2;
        vv.h[0] = *(const uint2*)vr; vv.h[1] = *(const uint2*)(vr + 32);
        o[dt][0] = __builtin_amdgcn_mfma_f32_16x16x32_bf16(vv.v, pf[0], o[dt][0], 0, 0, 0);
        o[dt][1] = __builtin_amdgcn_mfma_f32_16x16x32_bf16(vv.v, pf[1], o[dt][1], 0, 0, 0);
      }
    }
#pragma unroll
    for (int qt = 0; qt < 2; ++qt) {
      const size_t tok = (size_t)b * SEQ + t0 + q0 + qt * 16 + fr;
#pragma unroll
      for (int dt = 0; dt < 4; ++dt) {
        const int d = head * 64 + dt * 16 + fq * 4;
        const uint2 g = *(const uint2*)(p.projR + tok * RW + R_GA + d);
        const float g0 = bf_lo(g.x), g1 = bf_hi(g.x), g2 = bf_lo(g.y), g3 = bf_hi(g.y);
        const float v0 = o[dt][qt][0] * inv[qt] * siluf_(g0), v1 = o[dt][qt][1] * inv[qt] * siluf_(g1);
        const float v2 = o[dt][qt][2] * inv[qt] * siluf_(g2), v3 = o[dt][qt][3] * inv[qt] * siluf_(g3);
        *(uint2*)(ycat + tok * DM + 512 + d) = make_uint2(pk_bf16(v0, v1), pk_bf16(v2, v3));
      }
    }
  }
}

__device__ __forceinline__ void mixA_phase(const Params& p, int l, char* smem, f32x4 (&z)[4]) {
  const int nb = gridDim.x;
  if (nb > 128) {
    if ((int)blockIdx.x < 128) chunkscan_block(p, blockIdx.x, smem, 0, 256, z);
    else {
      chunkprep_phase(p, smem, 256, 8, blockIdx.x - 128, nb - 128);
    }
  } else {
    if (l == 0) weight_jobs(p, 1, blockIdx.x, nb, smem);
    for (int cb = blockIdx.x; cb < 128; cb += nb) { __syncthreads(); f32x4 zl[4]; chunkscan_block(p, cb, smem, 0, 512, zl); }
  }
}
__device__ __forceinline__ void mixB_phase(const Params& p, int l, char* smem, f32x4 (&z)[4]) {
  const int nb = gridDim.x;
  if (nb > 128) {
    if ((int)blockIdx.x < 128) chunkscan_block(p, blockIdx.x, smem, 256, 256, z);
    else {
      if (l == 0) weight_jobs(p, 1, blockIdx.x - 128, nb - 128, smem);
      attn_items(p, l, blockIdx.x - 128, nb - 128, smem);
    }
  } else attn_items(p, l, blockIdx.x, nb, smem);
}

__device__ __forceinline__ void post_phase(const Params& p, int l) {
  const float* gw = p.gn_w + l * 512; const float* gb = p.gn_b + l * 512;
  const u16* s_v = p.sc + 5 * SCN;
  u16* ycat = p.h;
  const int nthreads = gridDim.x * 256;
  for (int idx = blockIdx.x * 256 + threadIdx.x; idx < (NTOK / 4) * 128; idx += nthreads) {
    const int tok = (idx >> 7) * 4, c4 = (idx & 127) * 4, head = c4 >> 6;
    const int b = tok >> 13, t = tok & (SEQ - 1);
    f32x4 y[4];
#pragma unroll
    for (int r = 0; r < 4; ++r) { const uint2 yy = *(const uint2*)((const u16*)p.yraw + (size_t)(tok + r) * 512 + c4); y[r] = (f32x4){bf_lo(yy.x), bf_hi(yy.x), bf_lo(yy.y), bf_hi(yy.y)}; }
    const size_t so = ((size_t)(b * 8 + head) * SEQ + t);
    const u16* vch = s_v + (so & ~(size_t)15) * 64;
    const u16* vp = vch + ((((c4 & 63) >> 4) * 64 + (((t & 15) >> 2) << 4) + (c4 & 15)) * 4);
    uint2 ve[4];
#pragma unroll
    for (int j = 0; j < 4; ++j) ve[j] = *(const uint2*)(vp + j * 4);
    const f32x4 rk4 = *(const f32x4*)(p.rk + so);
    uint2 gg[4];
#pragma unroll
    for (int r = 0; r < 4; ++r) gg[r] = *(const uint2*)(p.projR + (size_t)(tok + r) * RW + R_G + c4);
    const f32x4 gwv = *(const f32x4*)(gw + c4), gbv = *(const f32x4*)(gb + c4);
#pragma unroll
    for (int r = 0; r < 4; ++r) {
      float s = (y[r][0] + y[r][1]) + (y[r][2] + y[r][3]);
      s += __shfl_xor(s, 1); s += __shfl_xor(s, 2); s += __shfl_xor(s, 4); s += __shfl_xor(s, 8);
      const float mean = s * (1.0f / 64.0f);
      const f32x4 d = y[r] - mean;
      float q = d[0] * d[0] + d[1] * d[1] + d[2] * d[2] + d[3] * d[3];
      q += __shfl_xor(q, 1); q += __shfl_xor(q, 2); q += __shfl_xor(q, 4); q += __shfl_xor(q, 8);
      const float rstd = rsqrtf(q * (1.0f / 64.0f) + 64e-5f);
      float v[4];
#pragma unroll
      for (int j = 0; j < 4; ++j) { const unsigned w = (r < 2) ? ve[j].x : ve[j].y; v[j] = (r & 1) ? bf_hi(w) : bf_lo(w); }
      const float g[4] = {bf_lo(gg[r].x), bf_hi(gg[r].x), bf_lo(gg[r].y), bf_hi(gg[r].y)};
      float o[4];
#pragma unroll
      for (int j = 0; j < 4; ++j) o[j] = (d[j] * rstd * gwv[j] + gbv[j] + rk4[r] * v[j]) * siluf_(g[j]);
      *(uint2*)(ycat + (size_t)(tok + r) * DM + c4) = make_uint2(pk_bf16(o[0], o[1]), pk_bf16(o[2], o[3]));
    }
  }
}

__global__ void __launch_bounds__(256, 2) mega(Params p, int ph_begin, int ph_end) {
  __shared__ __attribute__((aligned(16))) char smem[SMEM_BYTES];
  __shared__ __attribute__((aligned(16))) unsigned xb_st[4];
  if (p.never) cg::this_grid().sync();
  const unsigned xcc = xb_xcc_id();
  if (threadIdx.x == 0) { xb_st[0] = 0u; xb_st[1] = 0u; if (ph_end - ph_begin > 1) (void)xb_add(&p.bar[XB_XCNT(xcc)], 1u); }
  __syncthreads();
#define RUN_PHASE(K, STMT) if (ph_begin <= (K) && (K) < ph_end) { STMT; if ((K) + 1 < ph_end) { grid_barrier(p.bar, xcc, xb_st); } }
  const bool split = gridDim.x > 128;
  f32x4 zst[4];
#pragma unroll
  for (int jt = 0; jt < 4; ++jt) zst[jt] = (f32x4){0.f, 0.f, 0.f, 0.f};
  RUN_PHASE(0, phase0(p, smem))
  RUN_PHASE(1, gemm_phase<1>(p, p.h, p.WinT, nullptr, 27, smem))
  RUN_PHASE(2, prep_phase(p, 0, smem))
  RUN_PHASE(3, chunkprep_phase(p, smem, 0, split ? 8 : 9, blockIdx.x, gridDim.x))
  RUN_PHASE(4, mixA_phase(p, 0, smem, zst))
  RUN_PHASE(5, mixB_phase(p, 0, smem, zst))
  RUN_PHASE(6, post_phase(p, 0))
  RUN_PHASE(7, gemm_phase<2>(p, p.h, p.WoutT, p.x, 8, smem))
  RUN_PHASE(8, norm_rows_bf16(p.out, p.norm_gain + DM, p.h))
  RUN_PHASE(9, gemm_phase<1>(p, p.h, p.WinT + (size_t)INW * DM, nullptr, 27, smem))
  RUN_PHASE(10, prep_phase(p, 1, smem))
  RUN_PHASE(11, chunkprep_phase(p, smem, 0, split ? 8 : 9, blockIdx.x, gridDim.x))
  RUN_PHASE(12, mixA_phase(p, 1, smem, zst))
  RUN_PHASE(13, mixB_phase(p, 1, smem, zst))
  RUN_PHASE(14, post_phase(p, 1))
  RUN_PHASE(15, gemm_phase<2>(p, p.h, p.WoutT + (size_t)DM * DM, p.out, 8, smem))
  RUN_PHASE(16, norm_rows_f32_inplace(p.out, p.final_gain))
}

extern "C" void kernel_launch(void* const* d_in, const int* in_sizes, int n_in, void* d_out, int out_size, void* d_ws, size_t ws_size, hipStream_t stream) {
  Params p{};
  p.x = (const float*)d_in[0]; p.norm_gain = (const float*)d_in[1]; p.w_in = (const float*)d_in[2]; p.shift_mu = (const float*)d_in[3];
  p.w0 = (const float*)d_in[4]; p.w_up = (const float*)d_in[5]; p.a0 = (const float*)d_in[6]; p.a_up = (const float*)d_in[7];
  p.k_k = (const float*)d_in[8]; p.k_a = (const float*)d_in[9]; p.r_k = (const float*)d_in[10]; p.gn_w = (const float*)d_in[11];
  p.gn_b = (const float*)d_in[12]; p.sinks = (const float*)d_in[13]; p.w_out = (const float*)d_in[14]; p.final_gain = (const float*)d_in[15];
  p.out = (float*)d_out;
  char* w = (char*)d_ws; size_t off = 0;
  auto take = [&](size_t bytes) { char* r = w + off; off += (bytes + 255) & ~(size_t)255; return r; };
  p.bar = (unsigned*)take(16384);
  p.WinT = (u16*)take((size_t)2 * INW * DM * 2);
  p.WoutT = (u16*)take((size_t)2 * DM * DM * 2);
  p.WupT = (u16*)take((size_t)2 * 512 * 64 * 2);
  p.AupT = (u16*)take((size_t)2 * 512 * 64 * 2);
  p.h = (u16*)take((size_t)NTOK * DM * 2);
  p.projS = (u16*)take((size_t)NTOK * SHW * 2);
  p.yraw = (float*)p.projS;
  p.exy0 = (u16*)((char*)p.projS + (size_t)NTOK * 512 * 4);
  p.exg = (float*)((char*)p.projS + (size_t)NTOK * 512 * 4 + (size_t)16384 * 1024 * 2);
  p.projR = (u16*)take((size_t)NTOK * RW * 2);
  p.vT = (u16*)take((size_t)4 * 2 * 64 * SEQ * 2);
  p.sc = (u16*)take((size_t)6 * SCN * 2);
  p.rk = (float*)take((size_t)NTOK * 8 * 4);
  p.never = 0; p.pad = 0;
  static int grid_blocks = 0;
  if (!grid_blocks) {
    int dev = 0, cus = 0, per_cu = 0;
    hipGetDevice(&dev);
    hipDeviceGetAttribute(&cus, hipDeviceAttributeMultiprocessorCount, dev);
    hipOccupancyMaxActiveBlocksPerMultiprocessor(&per_cu, mega, 256, 0);
    if (per_cu > 2) per_cu = 2;
    if (per_cu < 1) per_cu = 1;
    grid_blocks = cus * per_cu;
  }
  hipMemsetAsync(p.bar, 0, 16384, stream);
#if MULTI_LAUNCH
  for (int ph = 0; ph < NPHASE; ++ph) {
    hipLaunchKernelGGL(mega, dim3(grid_blocks), dim3(256), 0, stream, p, ph, ph + 1);
  }
#else
  int b = 0, e = NPHASE;
  void* args[] = {&p, &b, &e};
  hipError_t err = hipLaunchCooperativeKernel((void*)mega, dim3(grid_blocks), dim3(256), args, 0, stream);
  if (err != hipSuccess) fprintf(stderr, "cooperative launch failed: %s (grid %d)\n", hipGetErrorString(err), grid_blocks);
#endif
}
```
